# Optimizing an MI355X kernel written in HIP

```python
import math
import jax, jax.numpy as jnp
from jax import lax
import numpy as np

D_MODEL = 1024
BATCH = 1
SEQ = 16384
DEPTH = 1

HEAD_DIM = 128
HEADS_PER_GROUP = 4
ATTN_GROUPS = ((128, 1), (512, 4), (2048, 16))
N_ATTN_GROUPS = len(ATTN_GROUPS)
ATTN_HEADS = HEADS_PER_GROUP * N_ATTN_GROUPS
ATTN_QK_WIDTH = ATTN_HEADS * HEAD_DIM
ATTN_OUT_WIDTH = HEADS_PER_GROUP * HEAD_DIM
BLOCK = 128
ROPE_THETA = 500000.0
ROPE_DIM = HEAD_DIM // 4
SSM_WIDTH = 512
SSM_GROUP = 16
SSM_GROUPS = SSM_WIDTH // SSM_GROUP
SSM_STATE = 64
DT_MIN = 0.001
DT_MAX = 0.1
D_FF = -(-8 * D_MODEL // (3 * 256)) * 256
PLE_DIM = 256
EPS = 1e-6
IN_WIDTH = 3 * ATTN_QK_WIDTH + SSM_WIDTH + 2 * D_MODEL

kernel_name = "hybrid_dilated_attn_s5_gated_block"


def rmsnorm(x, g):
    xf = x.astype(jnp.float32)
    y = xf * lax.rsqrt(jnp.mean(xf * xf, axis=-1, keepdims=True) + EPS)
    return (y * g.astype(jnp.float32)).astype(x.dtype)


def partial_rotary(x, positions):
    half = ROPE_DIM // 2
    inv_freq = ROPE_THETA ** (-jnp.arange(half, dtype=jnp.float32) * 2.0 / ROPE_DIM)
    ang = positions.astype(jnp.float32)[..., None] * inv_freq
    cos = jnp.cos(ang)[:, :, None, :]
    sin = jnp.sin(ang)[:, :, None, :]
    xr = x[..., :ROPE_DIM].astype(jnp.float32)
    x1, x2 = xr[..., :half], xr[..., half:]
    rot = jnp.concatenate([x1 * cos - x2 * sin, x2 * cos + x1 * sin], axis=-1).astype(x.dtype)
    return jnp.concatenate([rot, x[..., ROPE_DIM:]], axis=-1)


def dilated_band_attention(q, k, v, dilation, band):
    B, S, H, Dh = q.shape
    L = S // dilation
    Lp = -(-L // BLOCK) * BLOCK
    nb = Lp // BLOCK

    def to_sub(t):
        t = jnp.moveaxis(t.reshape(B, L, dilation, H, Dh), 2, 1)
        t = jnp.pad(t, ((0, 0), (0, 0), (0, Lp - L), (0, 0), (0, 0)))
        return t.reshape(B, dilation, nb, BLOCK, H, Dh)

    def with_prev(t):
        prev = jnp.pad(t, ((0, 0), (0, 0), (1, 0), (0, 0), (0, 0), (0, 0)))[:, :, :-1]
        return jnp.concatenate([prev, t], axis=3)

    def from_sub(t):
        rest = t.shape[4:]
        t = t.reshape((B, dilation, Lp) + rest)[:, :, :L]
        return jnp.moveaxis(t, 1, 2).reshape((B, S) + rest)

    qb = to_sub(q)
    kk = with_prev(to_sub(k))
    vv = with_prev(to_sub(v))
    scale = 1.0 / math.sqrt(Dh)
    s = jnp.einsum('brnqhd,brnkhd->brnhqk', qb, kk,
                   preferred_element_type=jnp.float32) * scale
    qi = jnp.arange(BLOCK)[:, None]
    kj = jnp.arange(2 * BLOCK)[None, :]
    rel = BLOCK + qi - kj
    in_band = (rel >= 0) & (rel <= band)
    not_first = (jnp.arange(nb) > 0)[:, None, None]
    valid = in_band[None] & (not_first | (kj >= BLOCK)[None])
    s = jnp.where(valid[None, None, :, None], s, -jnp.inf)
    m = jnp.max(s, axis=-1, keepdims=True)
    pexp = jnp.exp(s - m)
    den = jnp.sum(pexp, axis=-1, keepdims=True)
    o = jnp.einsum('brnhqk,brnkhd->brnqhd', pexp, vv.astype(jnp.float32))
    o = o / jnp.swapaxes(den[..., 0], -1, -2)[..., None]
    lse = jnp.swapaxes(m[..., 0] + jnp.log(den[..., 0]), -1, -2)
    return from_sub(o), from_sub(lse)


def _complex_affine_combine(e1, e2):
    a1r, a1i, b1r, b1i = e1
    a2r, a2i, b2r, b2i = e2
    ar = a1r * a2r - a1i * a2i
    ai = a1r * a2i + a1i * a2r
    br = a2r * b1r - a2i * b1i + b2r
    bi = a2r * b1i + a2i * b1r + b2i
    return (ar, ai, br, bi)


def s5_ssm(u, a_re, a_im, log_dt, b_re, b_im, c_re, c_im, d_skip):
    B, S, _ = u.shape
    uf = u.astype(jnp.float32).reshape(B, S, SSM_GROUPS, SSM_GROUP)
    dt = jnp.exp(log_dt.astype(jnp.float32))[:, None]
    lr = a_re.astype(jnp.float32)
    li = a_im.astype(jnp.float32)
    mag = jnp.exp(lr * dt)
    bar_re = mag * jnp.cos(li * dt)
    bar_im = mag * jnp.sin(li * dt)
    nr = bar_re - 1.0
    ni = bar_im
    den = lr * lr + li * li
    z_re = (nr * lr + ni * li) / den
    z_im = (ni * lr - nr * li) / den
    br_ = b_re.astype(jnp.float32)
    bi_ = b_im.astype(jnp.float32)
    bb_re = z_re[..., None] * br_ - z_im[..., None] * bi_
    bb_im = z_re[..., None] * bi_ + z_im[..., None] * br_
    bu_re = jnp.einsum('bsgc,gpc->bsgp', uf, bb_re)
    bu_im = jnp.einsum('bsgc,gpc->bsgp', uf, bb_im)
    ar = jnp.broadcast_to(bar_re, bu_re.shape)
    ai = jnp.broadcast_to(bar_im, bu_im.shape)
    _, _, h_re, h_im = lax.associative_scan(_complex_affine_combine, (ar, ai, bu_re, bu_im), axis=1)
    y = (jnp.einsum('bsgp,gcp->bsgc', h_re, c_re.astype(jnp.float32))
         - jnp.einsum('bsgp,gcp->bsgc', h_im, c_im.astype(jnp.float32))
         + d_skip.astype(jnp.float32) * uf)
    return y.reshape(B, S, SSM_WIDTH).astype(u.dtype)


def hybrid_layer(h, p_l, positions, g_mix, w_in, a_re, a_im, log_dt, b_re, b_im, c_re, c_im,
                 d_skip, w_attn_proj, w_glu_a, w_glu_b, w_out, g_ffn, w_ffn_gate, w_ffn_up,
                 w_ffn_down, w_ple_gate, w_ple_proj):
    B, S, _ = h.shape
    n = rmsnorm(h, g_mix)
    z = n @ w_in
    o0 = ATTN_QK_WIDTH
    q = z[..., 0:o0].reshape(B, S, ATTN_HEADS, HEAD_DIM)
    k = z[..., o0:2 * o0].reshape(B, S, ATTN_HEADS, HEAD_DIM)
    v = z[..., 2 * o0:3 * o0].reshape(B, S, ATTN_HEADS, HEAD_DIM)
    o1 = 3 * o0
    u = z[..., o1:o1 + SSM_WIDTH]
    o2 = o1 + SSM_WIDTH
    gate_attn = jax.nn.sigmoid(z[..., o2:o2 + D_MODEL])
    gate_ssm = jax.nn.sigmoid(z[..., o2 + D_MODEL:o2 + 2 * D_MODEL])

    q = partial_rotary(q, positions)
    k = partial_rotary(k, positions)
    outs = []
    lses = []
    for gi, (window, dilation) in enumerate(ATTN_GROUPS):
        hs = slice(gi * HEADS_PER_GROUP, (gi + 1) * HEADS_PER_GROUP)
        o_g, l_g = dilated_band_attention(q[:, :, hs], k[:, :, hs], v[:, :, hs],
                                          dilation, window // dilation)
        outs.append(o_g)
        lses.append(l_g)
    wts = jax.nn.softmax(jnp.stack(lses, axis=0), axis=0)
    attn = jnp.sum(wts[..., None] * jnp.stack(outs, axis=0), axis=0)
    attn_d = attn.reshape(B, S, ATTN_OUT_WIDTH).astype(h.dtype) @ w_attn_proj

    y = jax.nn.gelu(s5_ssm(u, a_re, a_im, log_dt, b_re, b_im, c_re, c_im, d_skip))
    ssm_d = (y @ w_glu_a) * jax.nn.sigmoid(y @ w_glu_b)

    h = h + (gate_attn * attn_d + gate_ssm * ssm_d) @ w_out

    n2 = rmsnorm(h, g_ffn)
    h = h + (jax.nn.silu(n2 @ w_ffn_gate) * (n2 @ w_ffn_up)) @ w_ffn_down

    h = h + jax.nn.sigmoid(h @ w_ple_gate) * (p_l.astype(h.dtype) @ w_ple_proj)
    return h


def setup_inputs(seed: int = 0) -> dict:
    key = jax.random.key(seed)
    ks = jax.random.split(key, 26)
    f32 = jnp.float32

    def nrm(k, shape, fan_in):
        return jax.random.normal(k, shape, f32) * (fan_in ** -0.5)

    x = jax.random.normal(ks[0], (BATCH, SEQ, D_MODEL), f32)
    p = jax.random.normal(ks[1], (DEPTH, BATCH, SEQ, PLE_DIM), f32)
    positions = jnp.broadcast_to(jnp.arange(SEQ, dtype=jnp.int32)[None, :], (BATCH, SEQ))
    g_mix = 1.0 + 0.05 * jax.random.normal(ks[2], (DEPTH, D_MODEL), f32)
    w_in = nrm(ks[3], (DEPTH, D_MODEL, IN_WIDTH), D_MODEL)
    a_re = -0.5 + 0.01 * jax.random.normal(ks[4], (DEPTH, SSM_GROUPS, SSM_STATE), f32)
    a_im = (jnp.pi * jnp.arange(SSM_STATE, dtype=f32)[None, None, :]
            + 0.01 * jax.random.normal(ks[5], (DEPTH, SSM_GROUPS, SSM_STATE), f32))
    log_dt = jax.random.uniform(ks[6], (DEPTH, SSM_GROUPS), f32,
                                minval=math.log(DT_MIN), maxval=math.log(DT_MAX))
    b_re = nrm(ks[7], (DEPTH, SSM_GROUPS, SSM_STATE, SSM_GROUP), 2 * SSM_GROUP)
    b_im = nrm(ks[8], (DEPTH, SSM_GROUPS, SSM_STATE, SSM_GROUP), 2 * SSM_GROUP)
    c_re = nrm(ks[9], (DEPTH, SSM_GROUPS, SSM_GROUP, SSM_STATE), SSM_STATE)
    c_im = nrm(ks[10], (DEPTH, SSM_GROUPS, SSM_GROUP, SSM_STATE), SSM_STATE)
    d_skip = jax.random.normal(ks[11], (DEPTH, SSM_GROUPS, SSM_GROUP), f32)
    w_attn_proj = nrm(ks[12], (DEPTH, ATTN_OUT_WIDTH, D_MODEL), ATTN_OUT_WIDTH)
    w_glu_a = nrm(ks[13], (DEPTH, SSM_WIDTH, D_MODEL), SSM_WIDTH)
    w_glu_b = nrm(ks[14], (DEPTH, SSM_WIDTH, D_MODEL), SSM_WIDTH)
    w_out = nrm(ks[15], (DEPTH, D_MODEL, D_MODEL), D_MODEL)
    g_ffn = 1.0 + 0.05 * jax.random.normal(ks[16], (DEPTH, D_MODEL), f32)
    w_ffn_gate = nrm(ks[17], (DEPTH, D_MODEL, D_FF), D_MODEL)
    w_ffn_up = nrm(ks[18], (DEPTH, D_MODEL, D_FF), D_MODEL)
    w_ffn_down = nrm(ks[19], (DEPTH, D_FF, D_MODEL), D_FF)
    w_ple_gate = nrm(ks[20], (DEPTH, D_MODEL, D_MODEL), D_MODEL)
    w_ple_proj = nrm(ks[21], (DEPTH, PLE_DIM, D_MODEL), PLE_DIM)
    g_final = 1.0 + 0.05 * jax.random.normal(ks[22], (D_MODEL,), f32)
    return {"x": x, "p": p, "positions": positions, "g_mix": g_mix, "w_in": w_in,
            "a_re": a_re, "a_im": a_im, "log_dt": log_dt, "b_re": b_re, "b_im": b_im,
            "c_re": c_re, "c_im": c_im, "d_skip": d_skip, "w_attn_proj": w_attn_proj,
            "w_glu_a": w_glu_a, "w_glu_b": w_glu_b, "w_out": w_out, "g_ffn": g_ffn,
            "w_ffn_gate": w_ffn_gate, "w_ffn_up": w_ffn_up, "w_ffn_down": w_ffn_down,
            "w_ple_gate": w_ple_gate, "w_ple_proj": w_ple_proj, "g_final": g_final}


def reference(x, p, positions, g_mix, w_in, a_re, a_im, log_dt, b_re, b_im, c_re, c_im, d_skip,
              w_attn_proj, w_glu_a, w_glu_b, w_out, g_ffn, w_ffn_gate, w_ffn_up, w_ffn_down,
              w_ple_gate, w_ple_proj, g_final):
    h = x
    for i in range(DEPTH):
        h = hybrid_layer(h, p[i], positions, g_mix[i], w_in[i], a_re[i], a_im[i], log_dt[i],
                         b_re[i], b_im[i], c_re[i], c_im[i], d_skip[i], w_attn_proj[i],
                         w_glu_a[i], w_glu_b[i], w_out[i], g_ffn[i], w_ffn_gate[i], w_ffn_up[i],
                         w_ffn_down[i], w_ple_gate[i], w_ple_proj[i])
    return rmsnorm(h, g_final)
```

```cpp
#include <hip/hip_runtime.h>
#include <hip/hip_cooperative_groups.h>
#include <cstdio>
#include <cstdint>
#include <cmath>
namespace cg = cooperative_groups;
namespace pg8 {
#define PG8_LAS __attribute__((address_space(3)))
typedef unsigned short bf16_t;
typedef short bf16x8 __attribute__((ext_vector_type(8)));
typedef float f32x4 __attribute__((ext_vector_type(4)));
typedef unsigned u32x4 __attribute__((ext_vector_type(4)));
constexpr int BM = 256, BK = 64, HALF = 128, HTB = HALF * BK * 2  , STAGE_BYTES = 8 * HTB, NXCD = 8, WGM = 8;

__host__ __device__ __forceinline__ int lds_byte(int r, int c) { const int st = (r >> 4) * 2 + (c >> 5), rr = r & 15, cc = c & 31, ob = rr * 64 + cc * 2; return st * 1024 + (ob ^ (((ob >> 9) & 1) << 5)); }
__host__ __device__ __forceinline__ void stage_rc(int b, int& R, int& C) { const int st = b / 1024, sb = b % 1024, swz = sb ^ (((sb >> 9) & 1) << 5); R = (st >> 1) * 16 + swz / 64; C = (st & 1) * 32 + (swz % 64) / 2; }
__host__ __device__ __forceinline__ int perm32(int rho) { const int n = rho >> 4, i = rho & 15; return 8 * (i >> 2) + 4 * n + (i & 3); }

struct Unit { int pm, pn; };
struct Gemm { const bf16_t* A; const bf16_t* Bt; int M, N, K; };

struct StaticOrder {
    int nM, nN, nwg, G, c;
    __host__ __device__ void init(int M, int N, int G_, int c_) { nM = M / BM; nN = N / BM; nwg = nM * nN; G = G_; c = c_; }
    __host__ __device__ bool next(int i, Unit& u) const {
        const long L = (long)i * G + c; if (L >= nwg) return false;
        int wgid = (int)L; { const int q = nwg / NXCD, r = nwg % NXCD, xcd = wgid % NXCD, off = wgid / NXCD; wgid = (xcd < r ? xcd * (q + 1) : r * (q + 1) + (xcd - r) * q) + off; }
        const int nig = WGM * nN, gid = wgid / nig, fm = gid * WGM, gsz = (nM - fm) < WGM ? (nM - fm) : WGM;
        u.pm = fm + ((wgid % nig) % gsz); u.pn = (wgid % nig) / gsz; return true;
    }
    __device__ __forceinline__ void a_ready(const Unit&) const {}
    __device__ __forceinline__ void done(const Unit&) const {}
};

__device__ __forceinline__ unsigned cvt_pk_bf16(float lo, float hi) { unsigned r; asm volatile("v_cvt_pk_bf16_f32 %0, %1, %2" : "=v"(r) : "v"(lo), "v"(hi)); return r; }
typedef float f32x2 __attribute__((ext_vector_type(2)));
template <class Epi, class Sched, bool ALIGN_EPI = false, bool SP2 = false>
__device__ __forceinline__ void gemm_phase(PG8_LAS unsigned char* lds, const Gemm g, const Sched& S, const Epi& E) {
    const int tid = threadIdx.x, wid = __builtin_amdgcn_readfirstlane(tid >> 6), lane = tid & 63, wr = wid >> 2, wc = wid & 3, fr = lane & 15, fq = lane >> 4;
    const int K = g.K, nt = K / BK;
    unsigned voffA[2], voffB[2];
#pragma unroll
    for (int i = 0; i < 2; ++i) { int R, C; stage_rc(tid * 16 + i * 8192, R, C); const int Rb = Epi::PERM ? ((R & ~31) + perm32(R & 31)) : R;
        voffA[i] = (unsigned)(R * K + C) * 2u; voffB[i] = (unsigned)(Rb * K + C) * 2u; }
    const size_t kstep = (size_t)(BK * 2);
    const size_t hstep = (size_t)HALF * K * 2;
    const size_t tstep = 2 * hstep;
    const unsigned ldsw = (unsigned)wid * 1024u;
    const int aoff = lds_byte(wr * 64 + fr, fq * 8), boff = lds_byte(wc * 32 + fr, fq * 8);
#define PG8_SA(b, h) (((b) * 2 + (h)) * HTB)
#define PG8_SB(b, h) ((4 + (b) * 2 + (h)) * HTB)
#define PG8_STAGE(bufoff, gbase, voff) do { _Pragma("unroll") for (int _i = 0; _i < 2; ++_i) \
        __builtin_amdgcn_global_load_lds((const unsigned*)((const char*)(gbase) + (voff)[_i]), (PG8_LAS unsigned*)(lds + (bufoff) + ldsw + _i * 8192), 16, 0, 0); } while (0)
#define PG8_LDA(dst, b, h) do { _Pragma("unroll") for (int m = 0; m < 4; ++m) _Pragma("unroll") for (int k = 0; k < 2; ++k) dst[m][k] = *(const PG8_LAS bf16x8*)(lds + PG8_SA(b, h) + aoff + m * 2048 + k * 1024); } while (0)
#define PG8_LDB(dst, b, h) do { _Pragma("unroll") for (int n = 0; n < 2; ++n) _Pragma("unroll") for (int k = 0; k < 2; ++k) dst[n][k] = *(const PG8_LAS bf16x8*)(lds + PG8_SB(b, h) + boff + n * 2048 + k * 1024); } while (0)
#define PG8_MMA(ai, bj, At, Bt) do { __builtin_amdgcn_s_setprio(1); _Pragma("unroll") for (int m = 0; m < 4; ++m) _Pragma("unroll") for (int n = 0; n < 2; ++n) _Pragma("unroll") for (int k = 0; k < 2; ++k) \
        acc[ai][bj][m][n] = __builtin_amdgcn_mfma_f32_16x16x32_bf16(Bt[n][k], At[m][k], acc[ai][bj][m][n], 0, 0, 0); __builtin_amdgcn_s_setprio(0); } while (0)
#define PG8_WAIT_V(n) asm volatile("s_waitcnt vmcnt(" #n ")" ::: "memory")
#define PG8_WAIT_L(n) asm volatile("s_waitcnt lgkmcnt(" #n ")" ::: "memory")
#define PG8_BAR __builtin_amdgcn_s_barrier()
#define PG8_SCHED __builtin_amdgcn_sched_barrier(0)
    Unit cur, nxt; int ui = 0;
    if (!S.next(0, cur)) return;
    f32x4 acc[2][2][4][2];
#pragma unroll
    for (int a = 0; a < 2; ++a)
#pragma unroll
        for (int b = 0; b < 2; ++b)
#pragma unroll
            for (int m = 0; m < 4; ++m)
#pragma unroll
                for (int n = 0; n < 2; ++n) acc[a][b][m][n] = (f32x4){0.f, 0.f, 0.f, 0.f};
    bf16x8 At[4][2], B0[2][2], B1[2][2];
    const char* cA = (const char*)g.A + (size_t)cur.pm * tstep; const char* cB = (const char*)g.Bt + (size_t)cur.pn * tstep;
    S.a_ready(cur);
    if constexpr (SP2) {
        PG8_STAGE(PG8_SB(0, 0), cB, voffB); PG8_STAGE(PG8_SB(0, 1), cB + hstep, voffB); PG8_STAGE(PG8_SA(0, 0), cA, voffA); PG8_STAGE(PG8_SA(0, 1), cA + hstep, voffA);
        if (wr == 1) PG8_BAR;
        PG8_WAIT_V(2); PG8_BAR;
        PG8_STAGE(PG8_SB(1, 0), cB + kstep, voffB); PG8_STAGE(PG8_SA(1, 0), cA + kstep, voffA); PG8_STAGE(PG8_SB(1, 1), cB + hstep + kstep, voffB);
        PG8_WAIT_V(6); PG8_BAR;
    } else {
        PG8_STAGE(PG8_SB(0, 0), cB, voffB); PG8_STAGE(PG8_SA(0, 0), cA, voffA); PG8_STAGE(PG8_SB(0, 1), cB + hstep, voffB); PG8_STAGE(PG8_SA(0, 1), cA + hstep, voffA);
        if (wr == 1) PG8_BAR;
        PG8_WAIT_V(4); PG8_BAR;
        PG8_STAGE(PG8_SB(1, 0), cB + kstep, voffB); PG8_STAGE(PG8_SA(1, 0), cA + kstep, voffA); PG8_STAGE(PG8_SB(1, 1), cB + hstep + kstep, voffB);
        PG8_WAIT_V(6); PG8_BAR;
    }
    for (;;) {
        const bool has_next = S.next(ui + 1, nxt);
        const char* nA = has_next ? (const char*)g.A + (size_t)nxt.pm * tstep : cA; const char* nB = has_next ? (const char*)g.Bt + (size_t)nxt.pn * tstep : cB;
        for (int t = 0; t < nt; t += 2) {
            const bool last = (t == nt - 2);
            const char* a1 = cA + (size_t)(t + 1) * kstep;
            const char* a2 = last ? nA : cA + (size_t)(t + 2) * kstep; const char* b2 = last ? nB : cB + (size_t)(t + 2) * kstep;
            const char* a3 = a2 + kstep; const char* b3 = b2 + kstep;
            if (last && has_next) S.a_ready(nxt);
            if constexpr (SP2) {
            PG8_LDB(B0, 0, 0); PG8_LDB(B1, 0, 1); PG8_SCHED; PG8_LDA(At, 0, 0); PG8_STAGE(PG8_SA(1, 1), a1 + hstep, voffA);
            PG8_WAIT_V(8); PG8_WAIT_L(0); PG8_BAR; PG8_MMA(0, 0, At, B0); PG8_MMA(0, 1, At, B1); PG8_BAR; PG8_SCHED;
            PG8_LDA(At, 0, 1); PG8_STAGE(PG8_SB(0, 0), b2, voffB); PG8_STAGE(PG8_SB(0, 1), b2 + hstep, voffB); PG8_STAGE(PG8_SA(0, 0), a2, voffA);
            PG8_WAIT_V(8); PG8_WAIT_L(0); PG8_BAR; PG8_MMA(1, 0, At, B0); PG8_MMA(1, 1, At, B1); PG8_BAR; PG8_SCHED;
            PG8_LDB(B0, 1, 0); PG8_LDB(B1, 1, 1); PG8_SCHED; PG8_LDA(At, 1, 0); PG8_STAGE(PG8_SA(0, 1), a2 + hstep, voffA);
            PG8_WAIT_V(8); PG8_WAIT_L(0); PG8_BAR; PG8_MMA(0, 0, At, B0); PG8_MMA(0, 1, At, B1); PG8_BAR; PG8_SCHED;
            PG8_LDA(At, 1, 1); PG8_STAGE(PG8_SB(1, 0), b3, voffB); PG8_STAGE(PG8_SB(1, 1), b3 + hstep, voffB); PG8_STAGE(PG8_SA(1, 0), a3, voffA);
            PG8_WAIT_V(8); PG8_WAIT_L(0); PG8_BAR; PG8_MMA(1, 0, At, B0); PG8_MMA(1, 1, At, B1); PG8_BAR; PG8_SCHED;
            } else {
            PG8_LDB(B0, 0, 0); PG8_SCHED; PG8_LDA(At, 0, 0); PG8_STAGE(PG8_SA(1, 1), a1 + hstep, voffA);
            PG8_WAIT_L(8); PG8_BAR; PG8_WAIT_L(0); PG8_MMA(0, 0, At, B0); PG8_BAR; PG8_SCHED;
            PG8_LDB(B1, 0, 1); PG8_STAGE(PG8_SB(0, 0), b2, voffB);
            PG8_BAR; PG8_WAIT_L(0); PG8_MMA(0, 1, At, B1); PG8_BAR;
            PG8_LDA(At, 0, 1); PG8_STAGE(PG8_SA(0, 0), a2, voffA);
            PG8_BAR; PG8_WAIT_L(0); PG8_MMA(1, 0, At, B0); PG8_BAR; PG8_SCHED;
            PG8_STAGE(PG8_SB(0, 1), b2 + hstep, voffB);
            PG8_WAIT_V(6); PG8_BAR; PG8_MMA(1, 1, At, B1); PG8_BAR;
            PG8_LDB(B0, 1, 0); PG8_SCHED; PG8_LDA(At, 1, 0); PG8_STAGE(PG8_SA(0, 1), a2 + hstep, voffA);
            PG8_WAIT_L(8); PG8_BAR; PG8_WAIT_L(0); PG8_MMA(0, 0, At, B0); PG8_BAR; PG8_SCHED;
            PG8_LDB(B1, 1, 1); PG8_STAGE(PG8_SB(1, 0), b3, voffB);
            PG8_BAR; PG8_WAIT_L(0); PG8_MMA(0, 1, At, B1); PG8_BAR;
            PG8_LDA(At, 1, 1); PG8_STAGE(PG8_SA(1, 0), a3, voffA);
            PG8_BAR; PG8_WAIT_L(0); PG8_MMA(1, 0, At, B0); PG8_BAR; PG8_SCHED;
            PG8_STAGE(PG8_SB(1, 1), b3 + hstep, voffB);
            PG8_WAIT_V(6); PG8_BAR; PG8_MMA(1, 1, At, B1); PG8_BAR;
            }
        }
        if constexpr (ALIGN_EPI) { if (wr == 0) PG8_BAR; }
        if constexpr (!Epi::AFTER_DRAIN) { E(acc, cur, wr, wc, fr, fq); S.done(cur); }
        if (!has_next) break;
#pragma unroll
        for (int a = 0; a < 2; ++a)
#pragma unroll
            for (int b = 0; b < 2; ++b)
#pragma unroll
                for (int m = 0; m < 4; ++m)
#pragma unroll
                    for (int n = 0; n < 2; ++n) acc[a][b][m][n] = (f32x4){0.f, 0.f, 0.f, 0.f};
        cur = nxt; cA = nA; cB = nB; ++ui;
        if constexpr (ALIGN_EPI) { if (wr == 1) PG8_BAR; }
    }
    PG8_WAIT_V(0);
    if constexpr (!ALIGN_EPI) { if (wr == 0) PG8_BAR; }
    PG8_BAR;
    if constexpr (Epi::AFTER_DRAIN) { E.fused(acc, cur, wr, wc, fr, fq, lds, wid, lane); S.done(cur); }
#undef PG8_SA
#undef PG8_SB
#undef PG8_STAGE
#undef PG8_LDA
#undef PG8_LDB
#undef PG8_MMA
#undef PG8_WAIT_V
#undef PG8_WAIT_L
#undef PG8_BAR
#undef PG8_SCHED
}
}

#ifndef MK_LAUNCHES
#define MK_LAUNCHES 1
#endif
#define GAS __attribute__((address_space(1)))
#define LAS __attribute__((address_space(3)))
typedef unsigned short bf16;
typedef unsigned v4u __attribute__((ext_vector_type(4)));
typedef unsigned v2u __attribute__((ext_vector_type(2)));
typedef float f32x4 __attribute__((ext_vector_type(4)));
typedef float f32x2 __attribute__((ext_vector_type(2)));
typedef short bf16x8 __attribute__((ext_vector_type(8)));
typedef short s16x4 __attribute__((ext_vector_type(4)));
#define LDS_WAIT() asm volatile("s_waitcnt lgkmcnt(0)" ::: "memory")

constexpr int NWAVES = 8, NTHR = 512;
constexpr int M = 16384, D = 1024, INW = 7168, QKW = 1536, SSMW = 512, DFF = 2816, PLE = 256;
constexpr int NPH = 12;
constexpr float EPS = 1e-6f;
constexpr float QSCALE = 0.08838834764831845f * 1.4426950408889634f;
constexpr size_t MiB = 1u << 20;
constexpr size_t WS_RS1 = 0, WS_SSQ1 = 1 * MiB, WS_SSQ3 = 2 * MiB, WS_ROPE = 3 * MiB, WS_LSE = 5 * MiB, WS_SSME = 6 * MiB;
constexpr size_t WS_WIN = 8 * MiB, WS_WPROJ = 22 * MiB, WS_WGLU = 23 * MiB, WS_WOUT = 25 * MiB, WS_WGU = 27 * MiB, WS_WDOWN = 38 * MiB, WS_WPLEG = 44 * MiB, WS_WPLEP = 46 * MiB;
constexpr size_t WS_Q = 48 * MiB, WS_K = 96 * MiB, WS_V = 144 * MiB, WS_GA = 192 * MiB, WS_GS = 224 * MiB, WS_END = 256 * MiB;
constexpr size_t WS_MRG = 48 * MiB, WS_PB = 80 * MiB, WS_PP = 192 * MiB, WS_H1B = 224 * MiB, WS_ACT = 48 * MiB, WS_H2B = 136 * MiB;
constexpr size_t DO_XB = 0, DO_ATT = 0, DO_Y = 16 * MiB, DO_U = 32 * MiB;
constexpr int LDS_BYTES = 147456;

typedef __bf16 bf16x2_t __attribute__((ext_vector_type(2)));
__device__ __forceinline__ unsigned pkbf(float lo, float hi) { const f32x2 v = {lo, hi}; const bf16x2_t b = __builtin_convertvector(v, bf16x2_t); return __builtin_bit_cast(unsigned, b); }
__device__ __forceinline__ float bflo(unsigned w) { return __uint_as_float(w << 16); }
__device__ __forceinline__ float bfhi(unsigned w) { return __uint_as_float(w & 0xffff0000u); }
__device__ __forceinline__ float sigmoidf_(float x) { return __builtin_amdgcn_rcpf(1.0f + __expf(-x)); }
__device__ __forceinline__ float wave_sum(float v) {
#pragma unroll
    for (int o = 1; o < 64; o <<= 1) v += __shfl_xor(v, o);
    return v;
}
__device__ __forceinline__ void sincos_acc(float xf, float& s, float& c) {
    const double x = (double)xf;
    const double n = __builtin_rint(x * 0.63661977236758134308);
    double r = __builtin_fma(-n, 1.57079632679489655800, x);
    r = __builtin_fma(-n, 6.12323399573676603587e-17, r);
    const double r2 = r * r;
    double sp = 2.7557319223985893e-06;
    sp = __builtin_fma(sp, r2, -1.9841269841269841e-04);
    sp = __builtin_fma(sp, r2, 8.3333333333333333e-03);
    sp = __builtin_fma(sp, r2, -1.6666666666666666e-01);
    const double sn = __builtin_fma(sp * r2, r, r);
    double cp = -2.7557319223985888e-07;
    cp = __builtin_fma(cp, r2, 2.4801587301587302e-05);
    cp = __builtin_fma(cp, r2, -1.3888888888888889e-03);
    cp = __builtin_fma(cp, r2, 4.1666666666666664e-02);
    cp = __builtin_fma(cp, r2, -0.5);
    const double cs = __builtin_fma(cp, r2, 1.0);
    const int q = ((int)n) & 3;
    const double ss = (q & 1) ? cs : sn, cc = (q & 1) ? sn : cs;
    s = (float)((q & 2) ? -ss : ss);
    c = (float)(((q + 1) & 2) ? -cc : cc);
}

__device__ __forceinline__ void tr_item(const float* W, int K, int N, bf16* WT, int ileave, const float* gk, LAS float* scr, int item, int lane) {
    const int nblk = N / 32, kb = item / nblk, nb = item % nblk, k0 = 64 * kb, n0 = 32 * nb;
#pragma unroll 8
    for (int i = 0; i < 32; ++i) { const int kk = 2 * i + (lane >> 5); float w = W[(size_t)(k0 + kk) * N + n0 + (lane & 31)]; if (gk) w *= gk[k0 + kk]; scr[kk * 33 + (lane & 31)] = w; }
    LDS_WAIT();
    const int c = lane & 7;
#pragma unroll
    for (int j = 0; j < 4; ++j) { const int n = (lane >> 3) + 8 * j; const LAS float* s = scr + (8 * c) * 33 + n;
        v4u o; o.x = pkbf(s[0 * 33], s[1 * 33]); o.y = pkbf(s[2 * 33], s[3 * 33]); o.z = pkbf(s[4 * 33], s[5 * 33]); o.w = pkbf(s[6 * 33], s[7 * 33]);
        const int nn = n0 + n; const int drow = ileave ? ((nn >> 7) * 256 + (ileave - 1) * 128 + (nn & 127)) : nn;
        *(v4u*)(WT + (size_t)drow * K + k0 + 8 * c) = o; }
    LDS_WAIT();
}

struct Args { const float* in[24]; float* out; unsigned char* ws; int ph_lo, ph_hi; };
typedef Args Ptrs;

__device__ __forceinline__ void p0_prologue(const Ptrs& P, LAS unsigned char* lds, int gw, int NGW, int wave, int lane, int gtid, int GT) {
    LAS float* scr = (LAS float*)(lds + wave * 16384);
    unsigned char* ws = P.ws;
    constexpr int I_IN = (D / 64) * (INW / 32), I_PROJ = (512 / 64) * (D / 32), I_GLU = I_PROJ, I_OUT = (D / 64) * (D / 32), I_G = (D / 64) * (DFF / 32), I_DN = (DFF / 64) * (D / 32),
                  I_PG = I_OUT, I_PP = (PLE / 64) * (D / 32);
    constexpr int NITEMS = I_IN + I_PROJ + 2 * I_GLU + I_OUT + 2 * I_G + I_DN + I_PG + I_PP;
    for (int it = gw; it < NITEMS; it += NGW) {
        int r = it;
        if (r < I_IN) { tr_item(P.in[4], D, INW, (bf16*)(ws + WS_WIN), 0, P.in[3], scr, r, lane); continue; } r -= I_IN;
        if (r < I_PROJ) { tr_item(P.in[13], 512, D, (bf16*)(ws + WS_WPROJ), 0, nullptr, scr, r, lane); continue; } r -= I_PROJ;
        if (r < I_GLU) { tr_item(P.in[14], 512, D, (bf16*)(ws + WS_WGLU), 1, nullptr, scr, r, lane); continue; } r -= I_GLU;
        if (r < I_GLU) { tr_item(P.in[15], 512, D, (bf16*)(ws + WS_WGLU), 2, nullptr, scr, r, lane); continue; } r -= I_GLU;
        if (r < I_OUT) { tr_item(P.in[16], D, D, (bf16*)(ws + WS_WOUT), 0, nullptr, scr, r, lane); continue; } r -= I_OUT;
        if (r < I_G) { tr_item(P.in[18], D, DFF, (bf16*)(ws + WS_WGU), 1, P.in[17], scr, r, lane); continue; } r -= I_G;
        if (r < I_G) { tr_item(P.in[19], D, DFF, (bf16*)(ws + WS_WGU), 2, P.in[17], scr, r, lane); continue; } r -= I_G;
        if (r < I_DN) { tr_item(P.in[20], DFF, D, (bf16*)(ws + WS_WDOWN), 0, nullptr, scr, r, lane); continue; } r -= I_DN;
        if (r < I_PG) { tr_item(P.in[21], D, D, (bf16*)(ws + WS_WPLEG), 0, nullptr, scr, r, lane); continue; } r -= I_PG;
        tr_item(P.in[22], PLE, D, (bf16*)(ws + WS_WPLEP), 0, nullptr, scr, r, lane);
    }
    bf16* XB = (bf16*)((unsigned char*)P.out + DO_XB); float* rs1 = (float*)(ws + WS_RS1);
    for (int m = gw; m < M; m += NGW) {
        const f32x4* xr = (const f32x4*)(P.in[0] + (size_t)m * D) + lane;
        f32x4 v[4]; float s = 0.f;
#pragma unroll
        for (int j = 0; j < 4; ++j) { v[j] = xr[64 * j]; s += (v[j].x * v[j].x + v[j].y * v[j].y) + (v[j].z * v[j].z + v[j].w * v[j].w); }
        s = wave_sum(s);
        if (lane == 0) rs1[m] = 1.0f / sqrtf(s * (1.0f / D) + EPS);
        v2u* o8 = (v2u*)(XB + (size_t)m * D) + lane;
#pragma unroll
        for (int j = 0; j < 4; ++j) { v2u w; w.x = pkbf(v[j].x, v[j].y); w.y = pkbf(v[j].z, v[j].w); o8[64 * j] = w; }
    }
    const int* pos = (const int*)P.in[2]; f32x2* rope = (f32x2*)(ws + WS_ROPE);
    for (int e = gtid; e < M * 16; e += GT) {
        const int t = e >> 4, i = e & 15;
        float invf;
        switch (i) { case 0: invf = 1.0f; break; case 1: invf = 0.44036659598350525f; break; case 2: invf = 0.1939227432012558f; break; case 3: invf = 0.08539710193872452f; break;
            case 4: invf = 0.03760603070259094f; break; case 5: invf = 0.016560440883040428f; break; case 6: invf = 0.007292664609849453f; break; case 7: invf = 0.0032114461064338684f; break;
            case 8: invf = 0.0014142135623842478f; break; case 9: invf = 0.0006227724370546639f; break; case 10: invf = 0.00027424818836152554f; break; case 11: invf = 0.00012076973507646471f; break;
            case 12: invf = 5.3182957344688475e-05f; break; case 13: invf = 2.34199997066753e-05f; break; case 14: invf = 1.0313385246263351e-05f; break; default: invf = 4.541670477919979e-06f; break; }
        const float ang = (float)pos[t] * invf; float s, c; sincos_acc(ang, s, c);
        rope[e] = (f32x2){c, s};
    }
}

struct EpiIn {
    static constexpr bool PERM = false, AFTER_DRAIN = false;
    bf16 *Q, *K, *V, *GA, *GS; float* U; const float* rs1; const f32x4* rope;
    __device__ __forceinline__ void operator()(const f32x4 (&acc)[2][2][4][2], const pg8::Unit& u, int wr, int wc, int fr, int fq) const {
        const int pn = u.pn, row0 = u.pm * 256 + wr * 64 + fr, cl = wc * 32 + 4 * fq;
        if (pn < 12) {
            bf16* dst = pn < 6 ? Q : K; const int ct = (pn < 6 ? pn : pn - 6) * 256; const float qs = pn < 6 ? QSCALE : 1.0f;
#pragma unroll
            for (int ai = 0; ai < 2; ++ai)
#pragma unroll
                for (int m = 0; m < 4; ++m) {
                    const int row = row0 + ai * 128 + m * 16; const float rs = rs1[row] * qs;
                    f32x4 ca = {1.f, 0.f, 1.f, 0.f}, cb = {1.f, 0.f, 1.f, 0.f};
                    if (wc == 0) { ca = rope[(size_t)row * 8 + 2 * fq]; cb = rope[(size_t)row * 8 + 2 * fq + 1]; }
                    const float cs[4] = {ca.x, ca.z, cb.x, cb.z}, sn[4] = {ca.y, ca.w, cb.y, cb.w};
#pragma unroll
                    for (int bj = 0; bj < 2; ++bj) {
                        f32x4 v0 = acc[ai][bj][m][0] * rs, v1 = acc[ai][bj][m][1] * rs;
                        if (wc == 0) {
                            f32x4 o0, o1;
#pragma unroll
                            for (int j = 0; j < 4; ++j) { o0[j] = v0[j] * cs[j] - v1[j] * sn[j]; o1[j] = v1[j] * cs[j] + v0[j] * sn[j]; }
                            v0 = o0; v1 = o1;
                        }
                        bf16* p = dst + (size_t)row * QKW + ct + bj * 128 + cl;
                        v2u w0, w1; w0.x = pkbf(v0[0], v0[1]); w0.y = pkbf(v0[2], v0[3]); w1.x = pkbf(v1[0], v1[1]); w1.y = pkbf(v1[2], v1[3]);
                        *(v2u*)p = w0; *(v2u*)(p + 16) = w1;
                    }
                }
        } else if (pn < 18) {
            const int ct = (pn - 12) * 256;
#pragma unroll
            for (int ai = 0; ai < 2; ++ai)
#pragma unroll
                for (int m = 0; m < 4; ++m) {
                    const int row = row0 + ai * 128 + m * 16; const float rs = rs1[row];
#pragma unroll
                    for (int bj = 0; bj < 2; ++bj) {
                        const f32x4 v0 = acc[ai][bj][m][0] * rs, v1 = acc[ai][bj][m][1] * rs;
                        bf16* p = V + (size_t)row * QKW + ct + bj * 128 + cl;
                        v2u w0, w1; w0.x = pkbf(v0[0], v0[1]); w0.y = pkbf(v0[2], v0[3]); w1.x = pkbf(v1[0], v1[1]); w1.y = pkbf(v1[2], v1[3]);
                        *(v2u*)p = w0; *(v2u*)(p + 16) = w1;
                    }
                }
        } else if (pn < 20) {
            const int ct = (pn - 18) * 256;
#pragma unroll
            for (int ai = 0; ai < 2; ++ai)
#pragma unroll
                for (int m = 0; m < 4; ++m) {
                    const int row = row0 + ai * 128 + m * 16; const float rs = rs1[row];
#pragma unroll
                    for (int bj = 0; bj < 2; ++bj) {
                        float* p = U + (size_t)row * SSMW + ct + bj * 128 + cl;
                        *(f32x4*)p = acc[ai][bj][m][0] * rs; *(f32x4*)(p + 16) = acc[ai][bj][m][1] * rs;
                    }
                }
        } else {
            bf16* dst = pn < 24 ? GA : GS; const int ct = (pn < 24 ? pn - 20 : pn - 24) * 256;
#pragma unroll
            for (int ai = 0; ai < 2; ++ai)
#pragma unroll
                for (int m = 0; m < 4; ++m) {
                    const int row = row0 + ai * 128 + m * 16; const float rs = rs1[row];
#pragma unroll
                    for (int bj = 0; bj < 2; ++bj) {
                        const f32x4 v0 = acc[ai][bj][m][0] * rs, v1 = acc[ai][bj][m][1] * rs;
                        bf16* p = dst + (size_t)row * D + ct + bj * 128 + cl;
                        v2u w0, w1; w0.x = pkbf(sigmoidf_(v0[0]), sigmoidf_(v0[1])); w0.y = pkbf(sigmoidf_(v0[2]), sigmoidf_(v0[3]));
                        w1.x = pkbf(sigmoidf_(v1[0]), sigmoidf_(v1[1])); w1.y = pkbf(sigmoidf_(v1[2]), sigmoidf_(v1[3]));
                        *(v2u*)p = w0; *(v2u*)(p + 16) = w1;
                    }
                }
        }
    }
};

struct EpiGlu {
    static constexpr bool PERM = true, AFTER_DRAIN = false;
    const bf16* GS; bf16* MRG;
    __device__ __forceinline__ void operator()(const f32x4 (&acc)[2][2][4][2], const pg8::Unit& u, int wr, int wc, int fr, int fq) const {
        const int row0 = u.pm * 256 + wr * 64 + fr, f0 = u.pn * 128 + wc * 32 + 8 * fq;
#pragma unroll
        for (int ai = 0; ai < 2; ++ai)
#pragma unroll
            for (int m = 0; m < 4; ++m) {
                const size_t off = (size_t)(row0 + ai * 128 + m * 16) * D + f0;
                const v4u g = *(const v4u*)(GS + off);
                const float gv[8] = {bflo(g.x), bfhi(g.x), bflo(g.y), bfhi(g.y), bflo(g.z), bfhi(g.z), bflo(g.w), bfhi(g.w)};
                float o[8];
#pragma unroll
                for (int n = 0; n < 2; ++n)
#pragma unroll
                    for (int j = 0; j < 4; ++j) o[4 * n + j] = gv[4 * n + j] * acc[ai][0][m][n][j] * sigmoidf_(acc[ai][1][m][n][j]);
                v4u w; w.x = pkbf(o[0], o[1]); w.y = pkbf(o[2], o[3]); w.z = pkbf(o[4], o[5]); w.w = pkbf(o[6], o[7]);
                *(v4u*)(MRG + off) = w;
            }
    }
};
struct EpiProj {
    static constexpr bool PERM = true, AFTER_DRAIN = false;
    const bf16* GA; bf16* MRG;
    __device__ __forceinline__ void operator()(const f32x4 (&acc)[2][2][4][2], const pg8::Unit& u, int wr, int wc, int fr, int fq) const {
        const int row0 = u.pm * 256 + wr * 64 + fr, c0 = u.pn * 256 + wc * 32 + 8 * fq;
#pragma unroll
        for (int ai = 0; ai < 2; ++ai)
#pragma unroll
            for (int m = 0; m < 4; ++m)
#pragma unroll
                for (int bj = 0; bj < 2; ++bj) {
                    const size_t off = (size_t)(row0 + ai * 128 + m * 16) * D + c0 + bj * 128;
                    const v4u g = *(const v4u*)(GA + off), p = *(const v4u*)(MRG + off);
                    const float gv[8] = {bflo(g.x), bfhi(g.x), bflo(g.y), bfhi(g.y), bflo(g.z), bfhi(g.z), bflo(g.w), bfhi(g.w)};
                    const float pv[8] = {bflo(p.x), bfhi(p.x), bflo(p.y), bfhi(p.y), bflo(p.z), bfhi(p.z), bflo(p.w), bfhi(p.w)};
                    float o[8];
#pragma unroll
                    for (int n = 0; n < 2; ++n)
#pragma unroll
                        for (int j = 0; j < 4; ++j) o[4 * n + j] = gv[4 * n + j] * acc[ai][bj][m][n][j] + pv[4 * n + j];
                    v4u w; w.x = pkbf(o[0], o[1]); w.y = pkbf(o[2], o[3]); w.z = pkbf(o[4], o[5]); w.w = pkbf(o[6], o[7]);
                    *(v4u*)(MRG + off) = w;
                }
    }
};
struct EpiStore {
    static constexpr bool PERM = true, AFTER_DRAIN = false;
    bf16* O; int ldc;
    __device__ __forceinline__ void operator()(const f32x4 (&acc)[2][2][4][2], const pg8::Unit& u, int wr, int wc, int fr, int fq) const {
        const int row0 = u.pm * 256 + wr * 64 + fr, c0 = u.pn * 256 + wc * 32 + 8 * fq;
#pragma unroll
        for (int ai = 0; ai < 2; ++ai)
#pragma unroll
            for (int m = 0; m < 4; ++m)
#pragma unroll
                for (int bj = 0; bj < 2; ++bj) {
                    const f32x4 v0 = acc[ai][bj][m][0], v1 = acc[ai][bj][m][1];
                    v4u w; w.x = pkbf(v0[0], v0[1]); w.y = pkbf(v0[2], v0[3]); w.z = pkbf(v1[0], v1[1]); w.w = pkbf(v1[2], v1[3]);
                    *(v4u*)(O + (size_t)(row0 + ai * 128 + m * 16) * ldc + c0 + bj * 128) = w;
                }
    }
};
template <int MODE, bool WB, bool SSQ> struct EpiRes {
    static constexpr bool PERM = false, AFTER_DRAIN = false;
    const float* base; float* out; bf16* ob; float* ssq; const bf16* PP;
    __device__ __forceinline__ void operator()(const f32x4 (&acc)[2][2][4][2], const pg8::Unit& u, int wr, int wc, int fr, int fq) const {
        const int row0 = u.pm * 256 + wr * 64 + fr, c0 = u.pn * 256 + wc * 32 + 4 * fq;
#pragma unroll
        for (int ai = 0; ai < 2; ++ai)
#pragma unroll
            for (int m = 0; m < 4; ++m) {
                const int row = row0 + ai * 128 + m * 16; float sq = 0.f;
#pragma unroll
                for (int bj = 0; bj < 2; ++bj)
#pragma unroll
                    for (int n = 0; n < 2; ++n) {
                        const size_t off = (size_t)row * D + c0 + bj * 128 + n * 16;
                        f32x4 a = acc[ai][bj][m][n];
                        if (MODE == 1) { const v2u pw = *(const v2u*)(PP + off); a[0] = sigmoidf_(a[0]) * bflo(pw.x); a[1] = sigmoidf_(a[1]) * bfhi(pw.x); a[2] = sigmoidf_(a[2]) * bflo(pw.y); a[3] = sigmoidf_(a[3]) * bfhi(pw.y); }
                        const f32x4 h = *(const f32x4*)(base + off) + a;
                        *(f32x4*)(out + off) = h;
                        if (WB) { v2u w; w.x = pkbf(h[0], h[1]); w.y = pkbf(h[2], h[3]); *(v2u*)(ob + off) = w; }
                        if (SSQ) sq += (h[0] * h[0] + h[1] * h[1]) + (h[2] * h[2] + h[3] * h[3]);
                    }
                if (SSQ) { sq += __shfl_xor(sq, 16); sq += __shfl_xor(sq, 32); if (fq == 0) ssq[(size_t)row * 16 + u.pn * 4 + wc] = sq; }
                asm volatile("" ::: "memory");
            }
    }
};
struct EpiSwiglu {
    static constexpr bool PERM = true, AFTER_DRAIN = false;
    const float* ssq; bf16* ACT;
    __device__ __forceinline__ void operator()(const f32x4 (&acc)[2][2][4][2], const pg8::Unit& u, int wr, int wc, int fr, int fq) const {
        const int row0 = u.pm * 256 + wr * 64 + fr, f0 = u.pn * 128 + wc * 32 + 8 * fq;
#pragma unroll
        for (int ai = 0; ai < 2; ++ai)
#pragma unroll
            for (int m = 0; m < 4; ++m) {
                const int row = row0 + ai * 128 + m * 16;
                const f32x4* sp = (const f32x4*)(ssq + (size_t)row * 16);
                const f32x4 s0 = sp[0], s1 = sp[1], s2 = sp[2], s3 = sp[3];
                const float tot = ((s0.x + s0.y) + (s0.z + s0.w)) + ((s1.x + s1.y) + (s1.z + s1.w)) + ((s2.x + s2.y) + (s2.z + s2.w)) + ((s3.x + s3.y) + (s3.z + s3.w));
                const float rs = 1.0f / sqrtf(tot * (1.0f / D) + EPS);
                float o[8];
#pragma unroll
                for (int n = 0; n < 2; ++n)
#pragma unroll
                    for (int j = 0; j < 4; ++j) { const float g = acc[ai][0][m][n][j] * rs, uu = acc[ai][1][m][n][j] * rs; o[4 * n + j] = g * sigmoidf_(g) * uu; }
                v4u w; w.x = pkbf(o[0], o[1]); w.y = pkbf(o[2], o[3]); w.z = pkbf(o[4], o[5]); w.w = pkbf(o[6], o[7]);
                *(v4u*)(ACT + (size_t)row * DFF + f0) = w;
            }
    }
};

constexpr int KV_STRIDE = 272;
constexpr int V_LDS_OFF = 256 * KV_STRIDE;
__device__ __forceinline__ void attn_unit(LAS unsigned char* lds, bf16* Q, const bf16* K, const bf16* V, float* LSE, int unit, int tid, int wid, int lane) {
    const int grp = unit >> 9, hh = (unit >> 7) & 3, rn = unit & 127;
    const int dl = grp == 0 ? 1 : (grp == 1 ? 4 : 16);
    const int r = rn % dl, n = rn / dl;
    const int col0 = (grp * 4 + hh) * 128;
    __syncthreads();
    {
        const int ch = tid & 15, rw = tid >> 4;
        for (int p0 = (n == 0 ? 128 : 0); p0 < 256; p0 += 128) {
            v4u kv[4], vv[4];
#pragma unroll
            for (int q = 0; q < 4; ++q) { const int kk = p0 + 32 * q + rw; const size_t tok = (size_t)((n - 1) * 128 + kk) * dl + r;
                kv[q] = *(const v4u*)(K + tok * QKW + col0 + ch * 8); vv[q] = *(const v4u*)(V + tok * QKW + col0 + ch * 8); }
#pragma unroll
            for (int q = 0; q < 4; ++q) { const int kk = p0 + 32 * q + rw;
                *(LAS v4u*)(lds + kk * KV_STRIDE + ch * 16) = kv[q]; *(LAS v4u*)(lds + V_LDS_OFF + kk * KV_STRIDE + ch * 16) = vv[q]; }
        }
    }
    __syncthreads();
    const int l16 = lane & 15, g = lane >> 4;
    const int qi = 16 * wid + l16;
    const size_t tokq = (size_t)(n * 128 + qi) * dl + r;
    bf16* qp = Q + tokq * QKW + col0;
    bf16x8 qf[4];
#pragma unroll
    for (int ks = 0; ks < 4; ++ks) qf[ks] = *(const bf16x8*)(qp + 32 * ks + 8 * g);
    f32x4 st[9];
    float mx = -INFINITY;
#pragma unroll
    for (int i = 0; i < 9; ++i) {
        const int c = wid + i;
        st[i] = (f32x4){0.f, 0.f, 0.f, 0.f};
        if (c >= 8 || n > 0) {
            const LAS unsigned char* kp = lds + (16 * c + l16) * KV_STRIDE + 16 * g;
#pragma unroll
            for (int ks = 0; ks < 4; ++ks) { const bf16x8 kf = *(const LAS bf16x8*)(kp + 64 * ks); st[i] = __builtin_amdgcn_mfma_f32_16x16x32_bf16(kf, qf[ks], st[i], 0, 0, 0); }
#pragma unroll
            for (int rr = 0; rr < 4; ++rr) { const int kk = 16 * c + 4 * g + rr; const bool ok = kk < 128 ? (kk >= qi) : (kk - 128 <= qi); st[i][rr] = ok ? st[i][rr] : -INFINITY; mx = fmaxf(mx, st[i][rr]); }
        } else {
            st[i] = (f32x4){-INFINITY, -INFINITY, -INFINITY, -INFINITY};
        }
    }
    mx = fmaxf(mx, __shfl_xor(mx, 16)); mx = fmaxf(mx, __shfl_xor(mx, 32));
    float den = 0.f; s16x4 pb[9];
#pragma unroll
    for (int i = 0; i < 9; ++i) {
        float p[4];
#pragma unroll
        for (int rr = 0; rr < 4; ++rr) { p[rr] = __builtin_amdgcn_exp2f(st[i][rr] - mx); den += p[rr]; }
        v2u w; w.x = pkbf(p[0], p[1]); w.y = pkbf(p[2], p[3]);
        pb[i] = __builtin_bit_cast(s16x4, w);
    }
    den += __shfl_xor(den, 16); den += __shfl_xor(den, 32);
    f32x4 ot[8];
#pragma unroll
    for (int nt = 0; nt < 8; ++nt) ot[nt] = (f32x4){0.f, 0.f, 0.f, 0.f};
#pragma unroll
    for (int i = 0; i < 9; ++i) {
        const int c = wid + i;
        if (c >= 8 || n > 0) {
            const LAS unsigned char* vp = lds + V_LDS_OFF + (16 * c + 4 * g + (l16 >> 2)) * KV_STRIDE + 8 * (l16 & 3);
#pragma unroll
            for (int nt = 0; nt < 8; ++nt) {
                const s16x4 vf = __builtin_bit_cast(s16x4, __builtin_amdgcn_ds_read_tr16_b64_v4i16((LAS s16x4*)(vp + 32 * nt)));
                ot[nt] = __builtin_amdgcn_mfma_f32_16x16x16bf16_1k(vf, pb[i], ot[nt], 0, 0, 0);
            }
        }
    }
    const float inv = 1.0f / den;
#pragma unroll
    for (int nt = 0; nt < 8; ++nt) { v2u w; w.x = pkbf(ot[nt][0] * inv, ot[nt][1] * inv); w.y = pkbf(ot[nt][2] * inv, ot[nt][3] * inv); *(v2u*)(qp + 16 * nt + 4 * g) = w; }
    if (g == 0) LSE[((size_t)grp * M + tokq) * 4 + hh] = mx + __builtin_amdgcn_logf(den);
}

__device__ __forceinline__ void merge_rows(const bf16* Q, const float* LSE, bf16* ATT, int gw, int NGW, int lane) {
    const int hh = lane >> 4, ch = lane & 15;
    for (int t = gw; t < M; t += NGW) {
        const float l0 = LSE[((size_t)0 * M + t) * 4 + hh], l1 = LSE[((size_t)1 * M + t) * 4 + hh], l2 = LSE[((size_t)2 * M + t) * 4 + hh];
        const float mx = fmaxf(l0, fmaxf(l1, l2));
        float w0 = __builtin_amdgcn_exp2f(l0 - mx), w1 = __builtin_amdgcn_exp2f(l1 - mx), w2 = __builtin_amdgcn_exp2f(l2 - mx);
        const float inv = 1.0f / (w0 + w1 + w2); w0 *= inv; w1 *= inv; w2 *= inv;
        const bf16* qb = Q + (size_t)t * QKW + hh * 128 + ch * 8;
        const v4u a = *(const v4u*)qb, b = *(const v4u*)(qb + 512), c = *(const v4u*)(qb + 1024);
        v4u o;
        o.x = pkbf(w0 * bflo(a.x) + w1 * bflo(b.x) + w2 * bflo(c.x), w0 * bfhi(a.x) + w1 * bfhi(b.x) + w2 * bfhi(c.x));
        o.y = pkbf(w0 * bflo(a.y) + w1 * bflo(b.y) + w2 * bflo(c.y), w0 * bfhi(a.y) + w1 * bfhi(b.y) + w2 * bfhi(c.y));
        o.z = pkbf(w0 * bflo(a.z) + w1 * bflo(b.z) + w2 * bflo(c.z), w0 * bfhi(a.z) + w1 * bfhi(b.z) + w2 * bfhi(c.z));
        o.w = pkbf(w0 * bflo(a.w) + w1 * bflo(b.w) + w2 * bflo(c.w), w0 * bfhi(a.w) + w1 * bfhi(b.w) + w2 * bfhi(c.w));
        *(v4u*)(ATT + (size_t)t * 512 + hh * 128 + ch * 8) = o;
    }
}

constexpr int SCH = 128, NCH = M / SCH;
struct SsmLane { float ar, ai; float bbr[16], bbi[16]; };
__device__ __forceinline__ void ssm_params(const Ptrs& P, int g, int p, SsmLane& L) {
    const float dt = expf(P.in[7][g]);
    const float lr = P.in[5][g * 64 + p], li = P.in[6][g * 64 + p];
    const float mag = expf(lr * dt); float sn, cs; sincos_acc(li * dt, sn, cs);
    L.ar = mag * cs; L.ai = mag * sn;
    const float nr = L.ar - 1.0f, ni = L.ai, den = lr * lr + li * li;
    const float zr = (nr * lr + ni * li) / den, zi = (ni * lr - nr * li) / den;
    const f32x4* br = (const f32x4*)(P.in[8] + (size_t)(g * 64 + p) * 16); const f32x4* bi = (const f32x4*)(P.in[9] + (size_t)(g * 64 + p) * 16);
#pragma unroll
    for (int q = 0; q < 4; ++q) { const f32x4 a = br[q], b = bi[q];
#pragma unroll
        for (int j = 0; j < 4; ++j) { L.bbr[4 * q + j] = zr * a[j] - zi * b[j]; L.bbi[4 * q + j] = zr * b[j] + zi * a[j]; } }
}
__device__ __forceinline__ void ssm_load_u(const float* U, int t0, int g, LAS float* ul, int lane) {
#pragma unroll
    for (int it = 0; it < 8; ++it) { const int row = it * 16 + (lane >> 2), q = lane & 3;
        const f32x4 v = *(const f32x4*)(U + (size_t)(t0 + row) * SSMW + g * 16 + 4 * q); *(LAS f32x4*)(ul + row * 16 + 4 * q) = v; }
    LDS_WAIT();
}
__device__ __forceinline__ void ssm_step(const SsmLane& L, const LAS float* urow, float& hr, float& hi) {
    const LAS f32x4* u4 = (const LAS f32x4*)urow;
    float bre = 0.f, bim = 0.f;
#pragma unroll
    for (int q = 0; q < 4; ++q) { const f32x4 u = u4[q];
#pragma unroll
        for (int j = 0; j < 4; ++j) { bre = fmaf(u[j], L.bbr[4 * q + j], bre); bim = fmaf(u[j], L.bbi[4 * q + j], bim); } }
    const float nr = fmaf(L.ar, hr, fmaf(-L.ai, hi, bre)), ni = fmaf(L.ar, hi, fmaf(L.ai, hr, bim));
    hr = nr; hi = ni;
}
__device__ __forceinline__ void ssm_pass1(const Ptrs& P, const float* U, f32x2* E, LAS unsigned char* lds, int gw, int NGW, int wave, int lane) {
    LAS float* ul = (LAS float*)(lds + wave * 16384);
    for (int unit = gw; unit < NCH * 32; unit += NGW) {
        const int g = unit & 31, c = unit >> 5;
        SsmLane L; ssm_params(P, g, lane, L);
        ssm_load_u(U, c * SCH, g, ul, lane);
        float hr = 0.f, hi = 0.f;
#pragma unroll 4
        for (int t = 0; t < SCH; ++t) ssm_step(L, ul + t * 16, hr, hi);
        E[(size_t)(c * 32 + g) * 64 + lane] = (f32x2){hr, hi};
        LDS_WAIT();
    }
}
__device__ __forceinline__ float gelu_tanh(float x) {
    const float z = 0.7978845608028654f * (x + 0.044715f * x * x * x);
    const float e = __expf(2.0f * z);
    const float th = 1.0f - 2.0f * __builtin_amdgcn_rcpf(1.0f + e);
    return 0.5f * x * (1.0f + th);
}
__device__ __forceinline__ void ssm_pass3(const Ptrs& P, const float* U, const f32x2* E, bf16* Y, LAS unsigned char* lds, int gw, int NGW, int wave, int lane) {
    LAS float* ul = (LAS float*)(lds + wave * 16384);
    LAS unsigned char* hl = lds + wave * 16384 + 8192;
    const int l16 = lane & 15, g4 = lane >> 4;
    for (int unit = gw; unit < NCH * 32; unit += NGW) {
        const int g = unit & 31, c = unit >> 5;
        SsmLane L; ssm_params(P, g, lane, L);
        bf16x8 cf[4];
#pragma unroll
        for (int ks = 0; ks < 4; ++ks) {
            const f32x4 cr = *(const f32x4*)(P.in[10] + (size_t)(g * 16 + l16) * 64 + 16 * ks + 4 * g4), ci = *(const f32x4*)(P.in[11] + (size_t)(g * 16 + l16) * 64 + 16 * ks + 4 * g4);
            v4u w; w.x = pkbf(cr[0], -ci[0]); w.y = pkbf(cr[1], -ci[1]); w.z = pkbf(cr[2], -ci[2]); w.w = pkbf(cr[3], -ci[3]);
            cf[ks] = __builtin_bit_cast(bf16x8, w);
        }
        const f32x4 dsk = *(const f32x4*)(P.in[12] + g * 16 + 4 * g4);
        ssm_load_u(U, c * SCH, g, ul, lane);
        float pr = L.ar, pi = L.ai;
#pragma unroll
        for (int s = 0; s < 7; ++s) { const float a = pr * pr - pi * pi, b = 2.0f * pr * pi; pr = a; pi = b; }
        float hr = 0.f, hi = 0.f;
        { int cc = 0;
          for (; cc + 8 <= c; cc += 8) { f32x2 e[8];
#pragma unroll
              for (int j = 0; j < 8; ++j) e[j] = E[(size_t)((cc + j) * 32 + g) * 64 + lane];
#pragma unroll
              for (int j = 0; j < 8; ++j) { const float nr = fmaf(pr, hr, fmaf(-pi, hi, e[j].x)), ni = fmaf(pr, hi, fmaf(pi, hr, e[j].y)); hr = nr; hi = ni; } }
          for (; cc < c; ++cc) { const f32x2 e = E[(size_t)(cc * 32 + g) * 64 + lane]; const float nr = fmaf(pr, hr, fmaf(-pi, hi, e.x)), ni = fmaf(pr, hi, fmaf(pi, hr, e.y)); hr = nr; hi = ni; } }
        for (int tb = 0; tb < SCH; tb += 16) {
#pragma unroll 4
            for (int tt = 0; tt < 16; ++tt) { ssm_step(L, ul + (tb + tt) * 16, hr, hi); *(LAS unsigned*)(hl + tt * 272 + lane * 4) = pkbf(hr, hi); }
            LDS_WAIT();
            f32x4 acc = {0.f, 0.f, 0.f, 0.f};
#pragma unroll
            for (int ks = 0; ks < 4; ++ks) { const bf16x8 hb = *(const LAS bf16x8*)(hl + l16 * 272 + 64 * ks + 16 * g4); acc = __builtin_amdgcn_mfma_f32_16x16x32_bf16(cf[ks], hb, acc, 0, 0, 0); }
            const f32x4 uu = *(const LAS f32x4*)(ul + (tb + l16) * 16 + 4 * g4);
            v2u w; w.x = pkbf(gelu_tanh(acc[0] + dsk[0] * uu[0]), gelu_tanh(acc[1] + dsk[1] * uu[1])); w.y = pkbf(gelu_tanh(acc[2] + dsk[2] * uu[2]), gelu_tanh(acc[3] + dsk[3] * uu[3]));
            *(v2u*)(Y + (size_t)(c * SCH + tb + l16) * SSMW + g * 16 + 4 * g4) = w;
            LDS_WAIT();
        }
    }
}

__global__ void __launch_bounds__(NTHR, 2) mk_fwd(Args args) {
    extern __shared__ __attribute__((aligned(16))) unsigned char lds_raw[];
    LAS unsigned char* lds = (LAS unsigned char*)lds_raw;
    cg::grid_group grid = cg::this_grid();
    const int tid = threadIdx.x, lane = tid & 63, wave = __builtin_amdgcn_readfirstlane(tid >> 6);
    const int G = gridDim.x, bid = blockIdx.x;
    const int gw = bid * NWAVES + wave, NGW = G * NWAVES, gtid = bid * NTHR + tid, GT = G * NTHR;
    const Args& P = args;
    const int lo = args.ph_lo, hi = args.ph_hi;
#ifndef PHMASK
#define PHMASK 0xFFFF
#endif
#define IN(k) (((PHMASK >> (k)) & 1) && lo <= (k) && (k) < hi)
#define SEAM(k) do { if (IN(k) && IN((k) + 1)) grid.sync(); } while (0)
#define Qb ((bf16*)(args.ws + WS_Q))
#define Kb ((bf16*)(args.ws + WS_K))
#define Vb ((bf16*)(args.ws + WS_V))
#define GA ((bf16*)(args.ws + WS_GA))
#define GS ((bf16*)(args.ws + WS_GS))
#define Ub ((float*)((unsigned char*)args.out + DO_U))
#define XB ((bf16*)((unsigned char*)args.out + DO_XB))
#define ATT ((bf16*)((unsigned char*)args.out + DO_ATT))
#define Yb ((bf16*)((unsigned char*)args.out + DO_Y))
#define LSE ((float*)(args.ws + WS_LSE))
#define SE ((f32x2*)(args.ws + WS_SSME))
#define MRG ((bf16*)(args.ws + WS_MRG))
#define PB ((bf16*)(args.ws + WS_PB))
#define PP ((bf16*)(args.ws + WS_PP))
#define H1B ((bf16*)(args.ws + WS_H1B))
#define ACT ((bf16*)(args.ws + WS_ACT))
#define H2B ((bf16*)(args.ws + WS_H2B))
#define ssq1 ((float*)(args.ws + WS_SSQ1))
#define ssq3 ((float*)(args.ws + WS_SSQ3))
    if (IN(0)) { p0_prologue(P, lds, gw, NGW, wave, lane, gtid, GT); }
    SEAM(0);
    if (IN(1)) {
        pg8::Gemm g{XB, (const bf16*)(args.ws + WS_WIN), M, INW, D}; pg8::StaticOrder S; S.init(M, INW, G, bid);
        EpiIn E{Qb, Kb, Vb, GA, GS, Ub, (const float*)(args.ws + WS_RS1), (const f32x4*)(args.ws + WS_ROPE)};
        pg8::gemm_phase<EpiIn, pg8::StaticOrder, true, true>(lds, g, S, E);
    }
    SEAM(1);
    if (IN(2)) {
        for (int unit = bid; unit < 1536; unit += G) attn_unit(lds, Qb, Kb, Vb, LSE, unit, tid, wave, lane);
        __syncthreads();
        ssm_pass1(P, Ub, SE, lds, gw, NGW, wave, lane);
    }
    SEAM(2);
    if (IN(3)) {
        merge_rows(Qb, LSE, ATT, gw, NGW, lane);
        ssm_pass3(P, Ub, SE, Yb, lds, gw, NGW, wave, lane);
        __syncthreads();
    }
    SEAM(3);
    if (IN(4)) {
        for (int m = gw; m < M; m += NGW) { const f32x4 v = *((const f32x4*)(P.in[1] + (size_t)m * PLE) + lane); v2u w; w.x = pkbf(v.x, v.y); w.y = pkbf(v.z, v.w); *((v2u*)(PB + (size_t)m * PLE) + lane) = w; }
        asm volatile("s_waitcnt vmcnt(0)" ::: "memory"); __syncthreads();
        pg8::Gemm g{Yb, (const bf16*)(args.ws + WS_WGLU), M, 2048, 512}; pg8::StaticOrder S; S.init(M, 2048, G, bid);
        EpiGlu E{GS, MRG};
        pg8::gemm_phase<EpiGlu, pg8::StaticOrder, true, true>(lds, g, S, E);
    }
    SEAM(4);
    if (IN(5)) {
        pg8::Gemm g{ATT, (const bf16*)(args.ws + WS_WPROJ), M, D, 512}; pg8::StaticOrder S; S.init(M, D, G, bid);
        EpiProj E{GA, MRG};
        pg8::gemm_phase<EpiProj, pg8::StaticOrder, true, true>(lds, g, S, E);
    }
    SEAM(5);
    if (IN(6)) {
        {
            pg8::Gemm g{MRG, (const bf16*)(args.ws + WS_WOUT), M, D, D}; pg8::StaticOrder S; S.init(M, D, G, bid);
            EpiRes<0, true, true> E{P.in[0], P.out, H1B, ssq1, nullptr};
            pg8::gemm_phase<EpiRes<0, true, true>, pg8::StaticOrder, true, true>(lds, g, S, E);
        }
    }
    if (IN(7)) {
        {
            int kple = PLE; asm volatile("" : "+s"(kple));
            pg8::Gemm g{PB, (const bf16*)(args.ws + WS_WPLEP), M, D, kple}; pg8::StaticOrder S; S.init(M, D, G, bid);
            EpiStore E{PP, D};
            pg8::gemm_phase<EpiStore, pg8::StaticOrder, true, true>(lds, g, S, E);
        }
    }
    SEAM(7);
    if (IN(8)) {
        pg8::Gemm g{H1B, (const bf16*)(args.ws + WS_WGU), M, 2 * DFF, D}; pg8::StaticOrder S; S.init(M, 2 * DFF, G, bid);
        EpiSwiglu E{ssq1, ACT};
        pg8::gemm_phase<EpiSwiglu, pg8::StaticOrder, true, true>(lds, g, S, E);
    }
    SEAM(8);
    if (IN(9)) {
        pg8::Gemm g{ACT, (const bf16*)(args.ws + WS_WDOWN), M, D, DFF}; pg8::StaticOrder S; S.init(M, D, G, bid);
        EpiRes<0, true, false> E{P.out, P.out, H2B, nullptr, nullptr};
        pg8::gemm_phase<EpiRes<0, true, false>, pg8::StaticOrder, true, true>(lds, g, S, E);
    }
    SEAM(9);
    if (IN(10)) {
        pg8::Gemm g{H2B, (const bf16*)(args.ws + WS_WPLEG), M, D, D}; pg8::StaticOrder S; S.init(M, D, G, bid);
        EpiRes<1, false, true> E{P.out, P.out, nullptr, ssq3, PP};
        pg8::gemm_phase<EpiRes<1, false, true>, pg8::StaticOrder, true, true>(lds, g, S, E);
    }
    SEAM(10);
    if (IN(11)) {
        const f32x4* gf = (const f32x4*)P.in[23];
        for (int m = gw; m < M; m += NGW) {
            const f32x4* sp = (const f32x4*)(ssq3 + (size_t)m * 16);
            const f32x4 s0 = sp[0], s1 = sp[1], s2 = sp[2], s3 = sp[3];
            const float tot = ((s0.x + s0.y) + (s0.z + s0.w)) + ((s1.x + s1.y) + (s1.z + s1.w)) + ((s2.x + s2.y) + (s2.z + s2.w)) + ((s3.x + s3.y) + (s3.z + s3.w));
            const float rs = 1.0f / sqrtf(tot * (1.0f / D) + EPS);
            f32x4* o = (f32x4*)(P.out + (size_t)m * D) + lane;
#pragma unroll
            for (int j = 0; j < 4; ++j) { const f32x4 h = o[64 * j]; o[64 * j] = h * rs * gf[64 * j + lane]; }
        }
    }
#undef IN
#undef SEAM
}

extern "C" void kernel_launch(void* const* d_in, const int* in_sizes, int n_in, void* d_out, int out_size, void* d_ws, size_t ws_size, hipStream_t stream) {
    static int grid = 0;
    if (grid == 0) {
        if (n_in != 24 || out_size != M * D || ws_size < WS_END) { fprintf(stderr, "kernel_launch: unexpected shapes (n_in %d out %d ws %zu)\n", n_in, out_size, ws_size); grid = -1; return; }
        int dev = 0, cus = 0, per_cu = 0;
        hipGetDevice(&dev); hipDeviceGetAttribute(&cus, hipDeviceAttributeMultiprocessorCount, dev);
        hipFuncSetAttribute((const void*)mk_fwd, hipFuncAttributeMaxDynamicSharedMemorySize, LDS_BYTES);
        if (hipOccupancyMaxActiveBlocksPerMultiprocessor(&per_cu, (const void*)mk_fwd, NTHR, LDS_BYTES) != hipSuccess || per_cu < 1) per_cu = 1;
        (void)hipGetLastError();
        grid = cus * per_cu;
    }
    if (grid < 0) return;
    Args a{};
    for (int i = 0; i < 24; ++i) a.in[i] = (const float*)d_in[i];
    a.out = (float*)d_out; a.ws = (unsigned char*)d_ws;
#if MK_LAUNCHES == 1
    a.ph_lo = 0; a.ph_hi = NPH;
    void* kargs[] = {&a};
    hipError_t e = hipLaunchCooperativeKernel((const void*)mk_fwd, dim3(grid), dim3(NTHR), kargs, LDS_BYTES, stream);
    if (e != hipSuccess) fprintf(stderr, "cooperative launch failed: %s (grid %d)\n", hipGetErrorString(e), grid);
#else
    for (int ph = 0; ph < NPH; ++ph) { a.ph_lo = ph; a.ph_hi = ph + 1; hipLaunchKernelGGL(mk_fwd, dim3(grid), dim3(NTHR), LDS_BYTES, stream, a); }
#endif
}
```

```cpp
#include <hip/hip_runtime.h>
#include <hip/hip_cooperative_groups.h>
#include <cstdio>
#include <cstdint>
#include <cmath>
namespace cg = cooperative_groups;
namespace pg8 {
#define PG8_LAS __attribute__((address_space(3)))
typedef unsigned short bf16_t;
typedef short bf16x8 __attribute__((ext_vector_type(8)));
typedef float f32x4 __attribute__((ext_vector_type(4)));
typedef unsigned u32x4 __attribute__((ext_vector_type(4)));
constexpr int BM = 256, BK = 64, HALF = 128, HTB = HALF * BK * 2  , STAGE_BYTES = 8 * HTB, NXCD = 8, WGM = 8;

__host__ __device__ __forceinline__ int lds_byte(int r, int c) { const int st = (r >> 4) * 2 + (c >> 5), rr = r & 15, cc = c & 31, ob = rr * 64 + cc * 2; return st * 1024 + (ob ^ (((ob >> 9) & 1) << 5)); }
__host__ __device__ __forceinline__ void stage_rc(int b, int& R, int& C) { const int st = b / 1024, sb = b % 1024, swz = sb ^ (((sb >> 9) & 1) << 5); R = (st >> 1) * 16 + swz / 64; C = (st & 1) * 32 + (swz % 64) / 2; }
__host__ __device__ __forceinline__ int perm32(int rho) { const int n = rho >> 4, i = rho & 15; return 8 * (i >> 2) + 4 * n + (i & 3); }

struct Unit { int pm, pn; };
struct Gemm { const bf16_t* A; const bf16_t* Bt; int M, N, K; };

struct StaticOrder {
    int nM, nN, nwg, G, c;
    __host__ __device__ void init(int M, int N, int G_, int c_) { nM = M / BM; nN = N / BM; nwg = nM * nN; G = G_; c = c_; }
    __host__ __device__ bool next(int i, Unit& u) const {
        const long L = (long)i * G + c; if (L >= nwg) return false;
        int wgid = (int)L; { const int q = nwg / NXCD, r = nwg % NXCD, xcd = wgid % NXCD, off = wgid / NXCD; wgid = (xcd < r ? xcd * (q + 1) : r * (q + 1) + (xcd - r) * q) + off; }
        const int nig = WGM * nN, gid = wgid / nig, fm = gid * WGM, gsz = (nM - fm) < WGM ? (nM - fm) : WGM;
        u.pm = fm + ((wgid % nig) % gsz); u.pn = (wgid % nig) / gsz; return true;
    }
    __device__ __forceinline__ void a_ready(const Unit&) const {}
    __device__ __forceinline__ void done(const Unit&) const {}
};

__device__ __forceinline__ unsigned cvt_pk_bf16(float lo, float hi) { unsigned r; asm volatile("v_cvt_pk_bf16_f32 %0, %1, %2" : "=v"(r) : "v"(lo), "v"(hi)); return r; }
typedef float f32x2 __attribute__((ext_vector_type(2)));
template <class Epi, class Sched, bool ALIGN_EPI = false, bool SP2 = false>
__device__ __forceinline__ void gemm_phase(PG8_LAS unsigned char* lds, const Gemm g, const Sched& S, const Epi& E) {
    const int tid = threadIdx.x, wid = __builtin_amdgcn_readfirstlane(tid >> 6), lane = tid & 63, wr = wid >> 2, wc = wid & 3, fr = lane & 15, fq = lane >> 4;
    const int K = g.K, nt = K / BK;
    unsigned voffA[2], voffB[2];
#pragma unroll
    for (int i = 0; i < 2; ++i) { int R, C; stage_rc(tid * 16 + i * 8192, R, C); const int Rb = Epi::PERM ? ((R & ~31) + perm32(R & 31)) : R;
        voffA[i] = (unsigned)(R * K + C) * 2u; voffB[i] = (unsigned)(Rb * K + C) * 2u; }
    const size_t kstep = (size_t)(BK * 2);
    const size_t hstep = (size_t)HALF * K * 2;
    const size_t tstep = 2 * hstep;
    const unsigned ldsw = (unsigned)wid * 1024u;
    const int aoff = lds_byte(wr * 64 + fr, fq * 8), boff = lds_byte(wc * 32 + fr, fq * 8);
#define PG8_SA(b, h) (((b) * 2 + (h)) * HTB)
#define PG8_SB(b, h) ((4 + (b) * 2 + (h)) * HTB)
#define PG8_STAGE(bufoff, gbase, voff) do { _Pragma("unroll") for (int _i = 0; _i < 2; ++_i) \
        __builtin_amdgcn_global_load_lds((const unsigned*)((const char*)(gbase) + (voff)[_i]), (PG8_LAS unsigned*)(lds + (bufoff) + ldsw + _i * 8192), 16, 0, 0); } while (0)
#define PG8_LDA(dst, b, h) do { _Pragma("unroll") for (int m = 0; m < 4; ++m) _Pragma("unroll") for (int k = 0; k < 2; ++k) dst[m][k] = *(const PG8_LAS bf16x8*)(lds + PG8_SA(b, h) + aoff + m * 2048 + k * 1024); } while (0)
#define PG8_LDB(dst, b, h) do { _Pragma("unroll") for (int n = 0; n < 2; ++n) _Pragma("unroll") for (int k = 0; k < 2; ++k) dst[n][k] = *(const PG8_LAS bf16x8*)(lds + PG8_SB(b, h) + boff + n * 2048 + k * 1024); } while (0)
#define PG8_MMA(ai, bj, At, Bt) do { __builtin_amdgcn_s_setprio(1); _Pragma("unroll") for (int m = 0; m < 4; ++m) _Pragma("unroll") for (int n = 0; n < 2; ++n) _Pragma("unroll") for (int k = 0; k < 2; ++k) \
        acc[ai][bj][m][n] = __builtin_amdgcn_mfma_f32_16x16x32_bf16(Bt[n][k], At[m][k], acc[ai][bj][m][n], 0, 0, 0); __builtin_amdgcn_s_setprio(0); } while (0)
#define PG8_WAIT_V(n) asm volatile("s_waitcnt vmcnt(" #n ")" ::: "memory")
#define PG8_WAIT_L(n) asm volatile("s_waitcnt lgkmcnt(" #n ")" ::: "memory")
#define PG8_BAR __builtin_amdgcn_s_barrier()
#define PG8_SCHED __builtin_amdgcn_sched_barrier(0)
    Unit cur, nxt; int ui = 0;
    if (!S.next(0, cur)) return;
    f32x4 acc[2][2][4][2];
#pragma unroll
    for (int a = 0; a < 2; ++a)
#pragma unroll
        for (int b = 0; b < 2; ++b)
#pragma unroll
            for (int m = 0; m < 4; ++m)
#pragma unroll
                for (int n = 0; n < 2; ++n) acc[a][b][m][n] = (f32x4){0.f, 0.f, 0.f, 0.f};
    bf16x8 At[4][2], B0[2][2], B1[2][2];
    const char* cA = (const char*)g.A + (size_t)cur.pm * tstep; const char* cB = (const char*)g.Bt + (size_t)cur.pn * tstep;
    S.a_ready(cur);
    if constexpr (SP2) {
        PG8_STAGE(PG8_SB(0, 0), cB, voffB); PG8_STAGE(PG8_SB(0, 1), cB + hstep, voffB); PG8_STAGE(PG8_SA(0, 0), cA, voffA); PG8_STAGE(PG8_SA(0, 1), cA + hstep, voffA);
        if (wr == 1) PG8_BAR;
        PG8_WAIT_V(2); PG8_BAR;
        PG8_STAGE(PG8_SB(1, 0), cB + kstep, voffB); PG8_STAGE(PG8_SA(1, 0), cA + kstep, voffA); PG8_STAGE(PG8_SB(1, 1), cB + hstep + kstep, voffB);
        PG8_WAIT_V(6); PG8_BAR;
    } else {
        PG8_STAGE(PG8_SB(0, 0), cB, voffB); PG8_STAGE(PG8_SA(0, 0), cA, voffA); PG8_STAGE(PG8_SB(0, 1), cB + hstep, voffB); PG8_STAGE(PG8_SA(0, 1), cA + hstep, voffA);
        if (wr == 1) PG8_BAR;
        PG8_WAIT_V(4); PG8_BAR;
        PG8_STAGE(PG8_SB(1, 0), cB + kstep, voffB); PG8_STAGE(PG8_SA(1, 0), cA + kstep, voffA); PG8_STAGE(PG8_SB(1, 1), cB + hstep + kstep, voffB);
        PG8_WAIT_V(6); PG8_BAR;
    }
    for (;;) {
        const bool has_next = S.next(ui + 1, nxt);
        const char* nA = has_next ? (const char*)g.A + (size_t)nxt.pm * tstep : cA; const char* nB = has_next ? (const char*)g.Bt + (size_t)nxt.pn * tstep : cB;
        for (int t = 0; t < nt; t += 2) {
            const bool last = (t == nt - 2);
            const char* a1 = cA + (size_t)(t + 1) * kstep;
            const char* a2 = last ? nA : cA + (size_t)(t + 2) * kstep; const char* b2 = last ? nB : cB + (size_t)(t + 2) * kstep;
            const char* a3 = a2 + kstep; const char* b3 = b2 + kstep;
            if (last && has_next) S.a_ready(nxt);
            if constexpr (SP2) {
            PG8_LDB(B0, 0, 0); PG8_LDB(B1, 0, 1); PG8_SCHED; PG8_LDA(At, 0, 0); PG8_STAGE(PG8_SA(1, 1), a1 + hstep, voffA);
            PG8_WAIT_V(8); PG8_WAIT_L(0); PG8_BAR; PG8_MMA(0, 0, At, B0); PG8_MMA(0, 1, At, B1); PG8_BAR; PG8_SCHED;
            PG8_LDA(At, 0, 1); PG8_STAGE(PG8_SB(0, 0), b2, voffB); PG8_STAGE(PG8_SB(0, 1), b2 + hstep, voffB); PG8_STAGE(PG8_SA(0, 0), a2, voffA);
            PG8_WAIT_V(8); PG8_WAIT_L(0); PG8_BAR; PG8_MMA(1, 0, At, B0); PG8_MMA(1, 1, At, B1); PG8_BAR; PG8_SCHED;
            PG8_LDB(B0, 1, 0); PG8_LDB(B1, 1, 1); PG8_SCHED; PG8_LDA(At, 1, 0); PG8_STAGE(PG8_SA(0, 1), a2 + hstep, voffA);
            PG8_WAIT_V(8); PG8_WAIT_L(0); PG8_BAR; PG8_MMA(0, 0, At, B0); PG8_MMA(0, 1, At, B1); PG8_BAR; PG8_SCHED;
            PG8_LDA(At, 1, 1); PG8_STAGE(PG8_SB(1, 0), b3, voffB); PG8_STAGE(PG8_SB(1, 1), b3 + hstep, voffB); PG8_STAGE(PG8_SA(1, 0), a3, voffA);
            PG8_WAIT_V(8); PG8_WAIT_L(0); PG8_BAR; PG8_MMA(1, 0, At, B0); PG8_MMA(1, 1, At, B1); PG8_BAR; PG8_SCHED;
            } else {
            PG8_LDB(B0, 0, 0); PG8_SCHED; PG8_LDA(At, 0, 0); PG8_STAGE(PG8_SA(1, 1), a1 + hstep, voffA);
            PG8_WAIT_L(8); PG8_BAR; PG8_WAIT_L(0); PG8_MMA(0, 0, At, B0); PG8_BAR; PG8_SCHED;
            PG8_LDB(B1, 0, 1); PG8_STAGE(PG8_SB(0, 0), b2, voffB);
            PG8_BAR; PG8_WAIT_L(0); PG8_MMA(0, 1, At, B1); PG8_BAR;
            PG8_LDA(At, 0, 1); PG8_STAGE(PG8_SA(0, 0), a2, voffA);
            PG8_BAR; PG8_WAIT_L(0); PG8_MMA(1, 0, At, B0); PG8_BAR; PG8_SCHED;
            PG8_STAGE(PG8_SB(0, 1), b2 + hstep, voffB);
            PG8_WAIT_V(6); PG8_BAR; PG8_MMA(1, 1, At, B1); PG8_BAR;
            PG8_LDB(B0, 1, 0); PG8_SCHED; PG8_LDA(At, 1, 0); PG8_STAGE(PG8_SA(0, 1), a2 + hstep, voffA);
            PG8_WAIT_L(8); PG8_BAR; PG8_WAIT_L(0); PG8_MMA(0, 0, At, B0); PG8_BAR; PG8_SCHED;
            PG8_LDB(B1, 1, 1); PG8_STAGE(PG8_SB(1, 0), b3, voffB);
            PG8_BAR; PG8_WAIT_L(0); PG8_MMA(0, 1, At, B1); PG8_BAR;
            PG8_LDA(At, 1, 1); PG8_STAGE(PG8_SA(1, 0), a3, voffA);
            PG8_BAR; PG8_WAIT_L(0); PG8_MMA(1, 0, At, B0); PG8_BAR; PG8_SCHED;
            PG8_STAGE(PG8_SB(1, 1), b3 + hstep, voffB);
            PG8_WAIT_V(6); PG8_BAR; PG8_MMA(1, 1, At, B1); PG8_BAR;
            }
        }
        if constexpr (ALIGN_EPI) { if (wr == 0) PG8_BAR; }
        if constexpr (!Epi::AFTER_DRAIN) { E(acc, cur, wr, wc, fr, fq); S.done(cur); }
        if (!has_next) break;
#pragma unroll
        for (int a = 0; a < 2; ++a)
#pragma unroll
            for (int b = 0; b < 2; ++b)
#pragma unroll
                for (int m = 0; m < 4; ++m)
#pragma unroll
                    for (int n = 0; n < 2; ++n) acc[a][b][m][n] = (f32x4){0.f, 0.f, 0.f, 0.f};
        cur = nxt; cA = nA; cB = nB; ++ui;
        if constexpr (ALIGN_EPI) { if (wr == 1) PG8_BAR; }
    }
    PG8_WAIT_V(0);
    if constexpr (!ALIGN_EPI) { if (wr == 0) PG8_BAR; }
    PG8_BAR;
    if constexpr (Epi::AFTER_DRAIN) { E.fused(acc, cur, wr, wc, fr, fq, lds, wid, lane); S.done(cur); }
#undef PG8_SA
#undef PG8_SB
#undef PG8_STAGE
#undef PG8_LDA
#undef PG8_LDB
#undef PG8_MMA
#undef PG8_WAIT_V
#undef PG8_WAIT_L
#undef PG8_BAR
#undef PG8_SCHED
}
}

#ifndef MK_LAUNCHES
#define MK_LAUNCHES 1
#endif
#define GAS __attribute__((address_space(1)))
#define LAS __attribute__((address_space(3)))
typedef unsigned short bf16;
typedef unsigned v4u __attribute__((ext_vector_type(4)));
typedef unsigned v2u __attribute__((ext_vector_type(2)));
typedef float f32x4 __attribute__((ext_vector_type(4)));
typedef float f32x2 __attribute__((ext_vector_type(2)));
typedef short bf16x8 __attribute__((ext_vector_type(8)));
typedef short s16x4 __attribute__((ext_vector_type(4)));
#define LDS_WAIT() asm volatile("s_waitcnt lgkmcnt(0)" ::: "memory")

constexpr int NWAVES = 8, NTHR = 512;
constexpr int M = 16384, D = 1024, INW = 7168, QKW = 1536, SSMW = 512, DFF = 2816, PLE = 256;
constexpr int NPH = 12;
constexpr float EPS = 1e-6f;
constexpr float QSCALE = 0.08838834764831845f * 1.4426950408889634f;
constexpr size_t MiB = 1u << 20;
constexpr size_t WS_RS1 = 0, WS_SSQ1 = 1 * MiB, WS_SSQ3 = 2 * MiB, WS_ROPE = 3 * MiB, WS_LSE = 5 * MiB, WS_SSME = 6 * MiB;
constexpr size_t WS_WIN = 8 * MiB, WS_WPROJ = 22 * MiB, WS_WGLU = 23 * MiB, WS_WOUT = 25 * MiB, WS_WGU = 27 * MiB, WS_WDOWN = 38 * MiB, WS_WPLEG = 44 * MiB, WS_WPLEP = 46 * MiB;
constexpr size_t WS_Q = 48 * MiB, WS_K = 96 * MiB, WS_V = 144 * MiB, WS_GA = 192 * MiB, WS_GS = 224 * MiB, WS_END = 256 * MiB;
constexpr size_t WS_MRG = 48 * MiB, WS_PB = 80 * MiB, WS_PP = 192 * MiB, WS_H1B = 224 * MiB, WS_ACT = 48 * MiB, WS_H2B = 136 * MiB;
constexpr size_t DO_XB = 0, DO_ATT = 0, DO_Y = 16 * MiB, DO_U = 32 * MiB;
constexpr int LDS_BYTES = 147456;

typedef __bf16 bf16x2_t __attribute__((ext_vector_type(2)));
__device__ __forceinline__ unsigned pkbf(float lo, float hi) { const f32x2 v = {lo, hi}; const bf16x2_t b = __builtin_convertvector(v, bf16x2_t); return __builtin_bit_cast(unsigned, b); }
__device__ __forceinline__ float bflo(unsigned w) { return __uint_as_float(w << 16); }
__device__ __forceinline__ float bfhi(unsigned w) { return __uint_as_float(w & 0xffff0000u); }
__device__ __forceinline__ float sigmoidf_(float x) { return __builtin_amdgcn_rcpf(1.0f + __expf(-x)); }
__device__ __forceinline__ float wave_sum(float v) {
#pragma unroll
    for (int o = 1; o < 64; o <<= 1) v += __shfl_xor(v, o);
    return v;
}
__device__ __forceinline__ void sincos_acc(float xf, float& s, float& c) {
    const double x = (double)xf;
    const double n = __builtin_rint(x * 0.63661977236758134308);
    double r = __builtin_fma(-n, 1.57079632679489655800, x);
    r = __builtin_fma(-n, 6.12323399573676603587e-17, r);
    const double r2 = r * r;
    double sp = 2.7557319223985893e-06;
    sp = __builtin_fma(sp, r2, -1.9841269841269841e-04);
    sp = __builtin_fma(sp, r2, 8.3333333333333333e-03);
    sp = __builtin_fma(sp, r2, -1.6666666666666666e-01);
    const double sn = __builtin_fma(sp * r2, r, r);
    double cp = -2.7557319223985888e-07;
    cp = __builtin_fma(cp, r2, 2.4801587301587302e-05);
    cp = __builtin_fma(cp, r2, -1.3888888888888889e-03);
    cp = __builtin_fma(cp, r2, 4.1666666666666664e-02);
    cp = __builtin_fma(cp, r2, -0.5);
    const double cs = __builtin_fma(cp, r2, 1.0);
    const int q = ((int)n) & 3;
    const double ss = (q & 1) ? cs : sn, cc = (q & 1) ? sn : cs;
    s = (float)((q & 2) ? -ss : ss);
    c = (float)(((q + 1) & 2) ? -cc : cc);
}

__device__ __forceinline__ void tr_item(const float* W, int K, int N, bf16* WT, int ileave, const float* gk, LAS float* scr, int item, int lane) {
    const int nblk = N / 32, kb = item / nblk, nb = item % nblk, k0 = 64 * kb, n0 = 32 * nb;
#pragma unroll 8
    for (int i = 0; i < 32; ++i) { const int kk = 2 * i + (lane >> 5); float w = W[(size_t)(k0 + kk) * N + n0 + (lane & 31)]; if (gk) w *= gk[k0 + kk]; scr[kk * 33 + (lane & 31)] = w; }
    LDS_WAIT();
    const int c = lane & 7;
#pragma unroll
    for (int j = 0; j < 4; ++j) { const int n = (lane >> 3) + 8 * j; const LAS float* s = scr + (8 * c) * 33 + n;
        v4u o; o.x = pkbf(s[0 * 33], s[1 * 33]); o.y = pkbf(s[2 * 33], s[3 * 33]); o.z = pkbf(s[4 * 33], s[5 * 33]); o.w = pkbf(s[6 * 33], s[7 * 33]);
        const int nn = n0 + n; const int drow = ileave ? ((nn >> 7) * 256 + (ileave - 1) * 128 + (nn & 127)) : nn;
        *(v4u*)(WT + (size_t)drow * K + k0 + 8 * c) = o; }
    LDS_WAIT();
}

struct Args { const float* in[24]; float* out; unsigned char* ws; int ph_lo, ph_hi; };
typedef Args Ptrs;

__device__ __forceinline__ void p0_prologue(const Ptrs& P, LAS unsigned char* lds, int gw, int NGW, int wave, int lane, int gtid, int GT) {
    LAS float* scr = (LAS float*)(lds + wave * 16384);
    unsigned char* ws = P.ws;
    constexpr int I_IN = (D / 64) * (INW / 32), I_PROJ = (512 / 64) * (D / 32), I_GLU = I_PROJ, I_OUT = (D / 64) * (D / 32), I_G = (D / 64) * (DFF / 32), I_DN = (DFF / 64) * (D / 32),
                  I_PG = I_OUT, I_PP = (PLE / 64) * (D / 32);
    constexpr int NITEMS = I_IN + I_PROJ + 2 * I_GLU + I_OUT + 2 * I_G + I_DN + I_PG + I_PP;
    for (int it = gw; it < NITEMS; it += NGW) {
        int r = it;
        if (r < I_IN) { tr_item(P.in[4], D, INW, (bf16*)(ws + WS_WIN), 0, P.in[3], scr, r, lane); continue; } r -= I_IN;
        if (r < I_PROJ) { tr_item(P.in[13], 512, D, (bf16*)(ws + WS_WPROJ), 0, nullptr, scr, r, lane); continue; } r -= I_PROJ;
        if (r < I_GLU) { tr_item(P.in[14], 512, D, (bf16*)(ws + WS_WGLU), 1, nullptr, scr, r, lane); continue; } r -= I_GLU;
        if (r < I_GLU) { tr_item(P.in[15], 512, D, (bf16*)(ws + WS_WGLU), 2, nullptr, scr, r, lane); continue; } r -= I_GLU;
        if (r < I_OUT) { tr_item(P.in[16], D, D, (bf16*)(ws + WS_WOUT), 0, nullptr, scr, r, lane); continue; } r -= I_OUT;
        if (r < I_G) { tr_item(P.in[18], D, DFF, (bf16*)(ws + WS_WGU), 1, P.in[17], scr, r, lane); continue; } r -= I_G;
        if (r < I_G) { tr_item(P.in[19], D, DFF, (bf16*)(ws + WS_WGU), 2, P.in[17], scr, r, lane); continue; } r -= I_G;
        if (r < I_DN) { tr_item(P.in[20], DFF, D, (bf16*)(ws + WS_WDOWN), 0, nullptr, scr, r, lane); continue; } r -= I_DN;
        if (r < I_PG) { tr_item(P.in[21], D, D, (bf16*)(ws + WS_WPLEG), 0, nullptr, scr, r, lane); continue; } r -= I_PG;
        tr_item(P.in[22], PLE, D, (bf16*)(ws + WS_WPLEP), 0, nullptr, scr, r, lane);
    }
    bf16* XB = (bf16*)((unsigned char*)P.out + DO_XB); float* rs1 = (float*)(ws + WS_RS1);
    for (int m = gw; m < M; m += NGW) {
        const f32x4* xr = (const f32x4*)(P.in[0] + (size_t)m * D) + lane;
        f32x4 v[4]; float s = 0.f;
#pragma unroll
        for (int j = 0; j < 4; ++j) { v[j] = xr[64 * j]; s += (v[j].x * v[j].x + v[j].y * v[j].y) + (v[j].z * v[j].z + v[j].w * v[j].w); }
        s = wave_sum(s);
        if (lane == 0) rs1[m] = 1.0f / sqrtf(s * (1.0f / D) + EPS);
        v2u* o8 = (v2u*)(XB + (size_t)m * D) + lane;
#pragma unroll
        for (int j = 0; j < 4; ++j) { v2u w; w.x = pkbf(v[j].x, v[j].y); w.y = pkbf(v[j].z, v[j].w); o8[64 * j] = w; }
    }
    const int* pos = (const int*)P.in[2]; f32x2* rope = (f32x2*)(ws + WS_ROPE);
    for (int e = gtid; e < M * 16; e += GT) {
        const int t = e >> 4, i = e & 15;
        float invf;
        switch (i) { case 0: invf = 1.0f; break; case 1: invf = 0.44036659598350525f; break; case 2: invf = 0.1939227432012558f; break; case 3: invf = 0.08539710193872452f; break;
            case 4: invf = 0.03760603070259094f; break; case 5: invf = 0.016560440883040428f; break; case 6: invf = 0.007292664609849453f; break; case 7: invf = 0.0032114461064338684f; break;
            case 8: invf = 0.0014142135623842478f; break; case 9: invf = 0.0006227724370546639f; break; case 10: invf = 0.00027424818836152554f; break; case 11: invf = 0.00012076973507646471f; break;
            case 12: invf = 5.3182957344688475e-05f; break; case 13: invf = 2.34199997066753e-05f; break; case 14: invf = 1.0313385246263351e-05f; break; default: invf = 4.541670477919979e-06f; break; }
        const float ang = (float)pos[t] * invf; float s, c; sincos_acc(ang, s, c);
        rope[e] = (f32x2){c, s};
    }
}

struct EpiIn {
    static constexpr bool PERM = false, AFTER_DRAIN = false;
    bf16 *Q, *K, *V, *GA, *GS; float* U; const float* rs1; const f32x4* rope;
    __device__ __forceinline__ void operator()(const f32x4 (&acc)[2][2][4][2], const pg8::Unit& u, int wr, int wc, int fr, int fq) const {
        const int pn = u.pn, row0 = u.pm * 256 + wr * 64 + fr, cl = wc * 32 + 4 * fq;
        if (pn < 12) {
            bf16* dst = pn < 6 ? Q : K; const int ct = (pn < 6 ? pn : pn - 6) * 256; const float qs = pn < 6 ? QSCALE : 1.0f;
#pragma unroll
            for (int ai = 0; ai < 2; ++ai)
#pragma unroll
                for (int m = 0; m < 4; ++m) {
                    const int row = row0 + ai * 128 + m * 16; const float rs = rs1[row] * qs;
                    f32x4 ca = {1.f, 0.f, 1.f, 0.f}, cb = {1.f, 0.f, 1.f, 0.f};
                    if (wc == 0) { ca = rope[(size_t)row * 8 + 2 * fq]; cb = rope[(size_t)row * 8 + 2 * fq + 1]; }
                    const float cs[4] = {ca.x, ca.z, cb.x, cb.z}, sn[4] = {ca.y, ca.w, cb.y, cb.w};
#pragma unroll
                    for (int bj = 0; bj < 2; ++bj) {
                        f32x4 v0 = acc[ai][bj][m][0] * rs, v1 = acc[ai][bj][m][1] * rs;
                        if (wc == 0) {
                            f32x4 o0, o1;
#pragma unroll
                            for (int j = 0; j < 4; ++j) { o0[j] = v0[j] * cs[j] - v1[j] * sn[j]; o1[j] = v1[j] * cs[j] + v0[j] * sn[j]; }
                            v0 = o0; v1 = o1;
                        }
                        bf16* p = dst + (size_t)row * QKW + ct + bj * 128 + cl;
                        v2u w0, w1; w0.x = pkbf(v0[0], v0[1]); w0.y = pkbf(v0[2], v0[3]); w1.x = pkbf(v1[0], v1[1]); w1.y = pkbf(v1[2], v1[3]);
                        *(v2u*)p = w0; *(v2u*)(p + 16) = w1;
                    }
                }
        } else if (pn < 18) {
            const int ct = (pn - 12) * 256;
#pragma unroll
            for (int ai = 0; ai < 2; ++ai)
#pragma unroll
                for (int m = 0; m < 4; ++m) {
                    const int row = row0 + ai * 128 + m * 16; const float rs = rs1[row];
#pragma unroll
                    for (int bj = 0; bj < 2; ++bj) {
                        const f32x4 v0 = acc[ai][bj][m][0] * rs, v1 = acc[ai][bj][m][1] * rs;
                        bf16* p = V + (size_t)row * QKW + ct + bj * 128 + cl;
                        v2u w0, w1; w0.x = pkbf(v0[0], v0[1]); w0.y = pkbf(v0[2], v0[3]); w1.x = pkbf(v1[0], v1[1]); w1.y = pkbf(v1[2], v1[3]);
                        *(v2u*)p = w0; *(v2u*)(p + 16) = w1;
                    }
                }
        } else if (pn < 20) {
            const int ct = (pn - 18) * 256;
#pragma unroll
            for (int ai = 0; ai < 2; ++ai)
#pragma unroll
                for (int m = 0; m < 4; ++m) {
                    const int row = row0 + ai * 128 + m * 16; const float rs = rs1[row];
#pragma unroll
                    for (int bj = 0; bj < 2; ++bj) {
                        float* p = U + (size_t)row * SSMW + ct + bj * 128 + cl;
                        *(f32x4*)p = acc[ai][bj][m][0] * rs; *(f32x4*)(p + 16) = acc[ai][bj][m][1] * rs;
                    }
                }
        } else {
            bf16* dst = pn < 24 ? GA : GS; const int ct = (pn < 24 ? pn - 20 : pn - 24) * 256;
#pragma unroll
            for (int ai = 0; ai < 2; ++ai)
#pragma unroll
                for (int m = 0; m < 4; ++m) {
                    const int row = row0 + ai * 128 + m * 16; const float rs = rs1[row];
#pragma unroll
                    for (int bj = 0; bj < 2; ++bj) {
                        const f32x4 v0 = acc[ai][bj][m][0] * rs, v1 = acc[ai][bj][m][1] * rs;
                        bf16* p = dst + (size_t)row * D + ct + bj * 128 + cl;
                        v2u w0, w1; w0.x = pkbf(sigmoidf_(v0[0]), sigmoidf_(v0[1])); w0.y = pkbf(sigmoidf_(v0[2]), sigmoidf_(v0[3]));
                        w1.x = pkbf(sigmoidf_(v1[0]), sigmoidf_(v1[1])); w1.y = pkbf(sigmoidf_(v1[2]), sigmoidf_(v1[3]));
                        *(v2u*)p = w0; *(v2u*)(p + 16) = w1;
                    }
                }
        }
    }
};

struct EpiGlu {
    static constexpr bool PERM = true, AFTER_DRAIN = false;
    const bf16* GS; bf16* MRG;
    __device__ __forceinline__ void operator()(const f32x4 (&acc)[2][2][4][2], const pg8::Unit& u, int wr, int wc, int fr, int fq) const {
        const int row0 = u.pm * 256 + wr * 64 + fr, f0 = u.pn * 128 + wc * 32 + 8 * fq;
#pragma unroll
        for (int ai = 0; ai < 2; ++ai)
#pragma unroll
            for (int m = 0; m < 4; ++m) {
                const size_t off = (size_t)(row0 + ai * 128 + m * 16) * D + f0;
                const v4u g = *(const v4u*)(GS + off);
                const float gv[8] = {bflo(g.x), bfhi(g.x), bflo(g.y), bfhi(g.y), bflo(g.z), bfhi(g.z), bflo(g.w), bfhi(g.w)};
                float o[8];
#pragma unroll
                for (int n = 0; n < 2; ++n)
#pragma unroll
                    for (int j = 0; j < 4; ++j) o[4 * n + j] = gv[4 * n + j] * acc[ai][0][m][n][j] * sigmoidf_(acc[ai][1][m][n][j]);
                v4u w; w.x = pkbf(o[0], o[1]); w.y = pkbf(o[2], o[3]); w.z = pkbf(o[4], o[5]); w.w = pkbf(o[6], o[7]);
                *(v4u*)(MRG + off) = w;
            }
    }
};
struct EpiProj {
    static constexpr bool PERM = true, AFTER_DRAIN = false;
    const bf16* GA; bf16* MRG;
    __device__ __forceinline__ void operator()(const f32x4 (&acc)[2][2][4][2], const pg8::Unit& u, int wr, int wc, int fr, int fq) const {
        const int row0 = u.pm * 256 + wr * 64 + fr, c0 = u.pn * 256 + wc * 32 + 8 * fq;
#pragma unroll
        for (int ai = 0; ai < 2; ++ai)
#pragma unroll
            for (int m = 0; m < 4; ++m)
#pragma unroll
                for (int bj = 0; bj < 2; ++bj) {
                    const size_t off = (size_t)(row0 + ai * 128 + m * 16) * D + c0 + bj * 128;
                    const v4u g = *(const v4u*)(GA + off), p = *(const v4u*)(MRG + off);
                    const float gv[8] = {bflo(g.x), bfhi(g.x), bflo(g.y), bfhi(g.y), bflo(g.z), bfhi(g.z), bflo(g.w), bfhi(g.w)};
                    const float pv[8] = {bflo(p.x), bfhi(p.x), bflo(p.y), bfhi(p.y), bflo(p.z), bfhi(p.z), bflo(p.w), bfhi(p.w)};
                    float o[8];
#pragma unroll
                    for (int n = 0; n < 2; ++n)
#pragma unroll
                        for (int j = 0; j < 4; ++j) o[4 * n + j] = gv[4 * n + j] * acc[ai][bj][m][n][j] + pv[4 * n + j];
                    v4u w; w.x = pkbf(o[0], o[1]); w.y = pkbf(o[2], o[3]); w.z = pkbf(o[4], o[5]); w.w = pkbf(o[6], o[7]);
                    *(v4u*)(MRG + off) = w;
                }
    }
};
struct EpiStore {
    static constexpr bool PERM = true, AFTER_DRAIN = false;
    bf16* O; int ldc;
    __device__ __forceinline__ void operator()(const f32x4 (&acc)[2][2][4][2], const pg8::Unit& u, int wr, int wc, int fr, int fq) const {
        const int row0 = u.pm * 256 + wr * 64 + fr, c0 = u.pn * 256 + wc * 32 + 8 * fq;
#pragma unroll
        for (int ai = 0; ai < 2; ++ai)
#pragma unroll
            for (int m = 0; m < 4; ++m)
#pragma unroll
                for (int bj = 0; bj < 2; ++bj) {
                    const f32x4 v0 = acc[ai][bj][m][0], v1 = acc[ai][bj][m][1];
                    v4u w; w.x = pkbf(v0[0], v0[1]); w.y = pkbf(v0[2], v0[3]); w.z = pkbf(v1[0], v1[1]); w.w = pkbf(v1[2], v1[3]);
                    *(v4u*)(O + (size_t)(row0 + ai * 128 + m * 16) * ldc + c0 + bj * 128) = w;
                }
    }
};
template <int MODE, bool WB, bool SSQ> struct EpiRes {
    static constexpr bool PERM = false, AFTER_DRAIN = false;
    const float* base; float* out; bf16* ob; float* ssq; const bf16* PP;
    __device__ __forceinline__ void operator()(const f32x4 (&acc)[2][2][4][2], const pg8::Unit& u, int wr, int wc, int fr, int fq) const {
        const int row0 = u.pm * 256 + wr * 64 + fr, c0 = u.pn * 256 + wc * 32 + 4 * fq;
#pragma unroll
        for (int ai = 0; ai < 2; ++ai)
#pragma unroll
            for (int m = 0; m < 4; ++m) {
                const int row = row0 + ai * 128 + m * 16; float sq = 0.f;
#pragma unroll
                for (int bj = 0; bj < 2; ++bj)
#pragma unroll
                    for (int n = 0; n < 2; ++n) {
                        const size_t off = (size_t)row * D + c0 + bj * 128 + n * 16;
                        f32x4 a = acc[ai][bj][m][n];
                        if (MODE == 1) { const v2u pw = *(const v2u*)(PP + off); a[0] = sigmoidf_(a[0]) * bflo(pw.x); a[1] = sigmoidf_(a[1]) * bfhi(pw.x); a[2] = sigmoidf_(a[2]) * bflo(pw.y); a[3] = sigmoidf_(a[3]) * bfhi(pw.y); }
                        const f32x4 h = *(const f32x4*)(base + off) + a;
                        *(f32x4*)(out + off) = h;
                        if (WB) { v2u w; w.x = pkbf(h[0], h[1]); w.y = pkbf(h[2], h[3]); *(v2u*)(ob + off) = w; }
                        if (SSQ) sq += (h[0] * h[0] + h[1] * h[1]) + (h[2] * h[2] + h[3] * h[3]);
                    }
                if (SSQ) { sq += __shfl_xor(sq, 16); sq += __shfl_xor(sq, 32); if (fq == 0) ssq[(size_t)row * 16 + u.pn * 4 + wc] = sq; }
                asm volatile("" ::: "memory");
            }
    }
};
struct EpiSwiglu {
    static constexpr bool PERM = true, AFTER_DRAIN = false;
    const float* ssq; bf16* ACT;
    __device__ __forceinline__ void operator()(const f32x4 (&acc)[2][2][4][2], const pg8::Unit& u, int wr, int wc, int fr, int fq) const {
        const int row0 = u.pm * 256 + wr * 64 + fr, f0 = u.pn * 128 + wc * 32 + 8 * fq;
#pragma unroll
        for (int ai = 0; ai < 2; ++ai)
#pragma unroll
            for (int m = 0; m < 4; ++m) {
                const int row = row0 + ai * 128 + m * 16;
                const f32x4* sp = (const f32x4*)(ssq + (size_t)row * 16);
                const f32x4 s0 = sp[0], s1 = sp[1], s2 = sp[2], s3 = sp[3];
                const float tot = ((s0.x + s0.y) + (s0.z + s0.w)) + ((s1.x + s1.y) + (s1.z + s1.w)) + ((s2.x + s2.y) + (s2.z + s2.w)) + ((s3.x + s3.y) + (s3.z + s3.w));
                const float rs = 1.0f / sqrtf(tot * (1.0f / D) + EPS);
                float o[8];
#pragma unroll
                for (int n = 0; n < 2; ++n)
#pragma unroll
                    for (int j = 0; j < 4; ++j) { const float g = acc[ai][0][m][n][j] * rs, uu = acc[ai][1][m][n][j] * rs; o[4 * n + j] = g * sigmoidf_(g) * uu; }
                v4u w; w.x = pkbf(o[0], o[1]); w.y = pkbf(o[2], o[3]); w.z = pkbf(o[4], o[5]); w.w = pkbf(o[6], o[7]);
                *(v4u*)(ACT + (size_t)row * DFF + f0) = w;
            }
    }
};

constexpr int KV_STRIDE = 272;
constexpr int V_LDS_OFF = 256 * KV_STRIDE;
__device__ __forceinline__ void attn_unit(LAS unsigned char* lds, bf16* Q, const bf16* K, const bf16* V, float* LSE, int unit, int tid, int wid, int lane) {
    const int grp = unit >> 9, hh = (unit >> 7) & 3, rn = unit & 127;
    const int dl = grp == 0 ? 1 : (grp == 1 ? 4 : 16);
    const int r = rn % dl, n = rn / dl;
    const int col0 = (grp * 4 + hh) * 128;
    __syncthreads();
    {
        const int ch = tid & 15, rw = tid >> 4;
        for (int p0 = (n == 0 ? 128 : 0); p0 < 256; p0 += 128) {
            v4u kv[4], vv[4];
#pragma unroll
            for (int q = 0; q < 4; ++q) { const int kk = p0 + 32 * q + rw; const size_t tok = (size_t)((n - 1) * 128 + kk) * dl + r;
                kv[q] = *(const v4u*)(K + tok * QKW + col0 + ch * 8); vv[q] = *(const v4u*)(V + tok * QKW + col0 + ch * 8); }
#pragma unroll
            for (int q = 0; q < 4; ++q) { const int kk = p0 + 32 * q + rw;
                *(LAS v4u*)(lds + kk * KV_STRIDE + ch * 16) = kv[q]; *(LAS v4u*)(lds + V_LDS_OFF + kk * KV_STRIDE + ch * 16) = vv[q]; }
        }
    }
    __syncthreads();
    const int l16 = lane & 15, g = lane >> 4;
    const int qi = 16 * wid + l16;
    const size_t tokq = (size_t)(n * 128 + qi) * dl + r;
    bf16* qp = Q + tokq * QKW + col0;
    bf16x8 qf[4];
#pragma unroll
    for (int ks = 0; ks < 4; ++ks) qf[ks] = *(const bf16x8*)(qp + 32 * ks + 8 * g);
    f32x4 st[9];
    float mx = -INFINITY;
#pragma unroll
    for (int i = 0; i < 9; ++i) {
        const int c = wid + i;
        st[i] = (f32x4){0.f, 0.f, 0.f, 0.f};
        if (c >= 8 || n > 0) {
            const LAS unsigned char* kp = lds + (16 * c + l16) * KV_STRIDE + 16 * g;
#pragma unroll
            for (int ks = 0; ks < 4; ++ks) { const bf16x8 kf = *(const LAS bf16x8*)(kp + 64 * ks); st[i] = __builtin_amdgcn_mfma_f32_16x16x32_bf16(kf, qf[ks], st[i], 0, 0, 0); }
#pragma unroll
            for (int rr = 0; rr < 4; ++rr) { const int kk = 16 * c + 4 * g + rr; const bool ok = kk < 128 ? (kk >= qi) : (kk - 128 <= qi); st[i][rr] = ok ? st[i][rr] : -INFINITY; mx = fmaxf(mx, st[i][rr]); }
        } else {
            st[i] = (f32x4){-INFINITY, -INFINITY, -INFINITY, -INFINITY};
        }
    }
    mx = fmaxf(mx, __shfl_xor(mx, 16)); mx = fmaxf(mx, __shfl_xor(mx, 32));
    float den = 0.f; s16x4 pb[9];
#pragma unroll
    for (int i = 0; i < 9; ++i) {
        float p[4];
#pragma unroll
        for (int rr = 0; rr < 4; ++rr) { p[rr] = __builtin_amdgcn_exp2f(st[i][rr] - mx); den += p[rr]; }
        v2u w; w.x = pkbf(p[0], p[1]); w.y = pkbf(p[2], p[3]);
        pb[i] = __builtin_bit_cast(s16x4, w);
    }
    den += __shfl_xor(den, 16); den += __shfl_xor(den, 32);
    f32x4 ot[8];
#pragma unroll
    for (int nt = 0; nt < 8; ++nt) ot[nt] = (f32x4){0.f, 0.f, 0.f, 0.f};
#pragma unroll
    for (int i = 0; i < 9; ++i) {
        const int c = wid + i;
        if (c >= 8 || n > 0) {
            const LAS unsigned char* vp = lds + V_LDS_OFF + (16 * c + 4 * g + (l16 >> 2)) * KV_STRIDE + 8 * (l16 & 3);
#pragma unroll
            for (int nt = 0; nt < 8; ++nt) {
                const s16x4 vf = __builtin_bit_cast(s16x4, __builtin_amdgcn_ds_read_tr16_b64_v4i16((LAS s16x4*)(vp + 32 * nt)));
                ot[nt] = __builtin_amdgcn_mfma_f32_16x16x16bf16_1k(vf, pb[i], ot[nt], 0, 0, 0);
            }
        }
    }
    const float inv = 1.0f / den;
#pragma unroll
    for (int nt = 0; nt < 8; ++nt) { v2u w; w.x = pkbf(ot[nt][0] * inv, ot[nt][1] * inv); w.y = pkbf(ot[nt][2] * inv, ot[nt][3] * inv); *(v2u*)(qp + 16 * nt + 4 * g) = w; }
    if (g == 0) LSE[((size_t)grp * M + tokq) * 4 + hh] = mx + __builtin_amdgcn_logf(den);
}

__device__ __forceinline__ void merge_rows(const bf16* Q, const float* LSE, bf16* ATT, int gw, int NGW, int lane) {
    const int hh = lane >> 4, ch = lane & 15;
    for (int t = gw; t < M; t += NGW) {
        const float l0 = LSE[((size_t)0 * M + t) * 4 + hh], l1 = LSE[((size_t)1 * M + t) * 4 + hh], l2 = LSE[((size_t)2 * M + t) * 4 + hh];
        const float mx = fmaxf(l0, fmaxf(l1, l2));
        float w0 = __builtin_amdgcn_exp2f(l0 - mx), w1 = __builtin_amdgcn_exp2f(l1 - mx), w2 = __builtin_amdgcn_exp2f(l2 - mx);
        const float inv = 1.0f / (w0 + w1 + w2); w0 *= inv; w1 *= inv; w2 *= inv;
        const bf16* qb = Q + (size_t)t * QKW + hh * 128 + ch * 8;
        const v4u a = *(const v4u*)qb, b = *(const v4u*)(qb + 512), c = *(const v4u*)(qb + 1024);
        v4u o;
        o.x = pkbf(w0 * bflo(a.x) + w1 * bflo(b.x) + w2 * bflo(c.x), w0 * bfhi(a.x) + w1 * bfhi(b.x) + w2 * bfhi(c.x));
        o.y = pkbf(w0 * bflo(a.y) + w1 * bflo(b.y) + w2 * bflo(c.y), w0 * bfhi(a.y) + w1 * bfhi(b.y) + w2 * bfhi(c.y));
        o.z = pkbf(w0 * bflo(a.z) + w1 * bflo(b.z) + w2 * bflo(c.z), w0 * bfhi(a.z) + w1 * bfhi(b.z) + w2 * bfhi(c.z));
        o.w = pkbf(w0 * bflo(a.w) + w1 * bflo(b.w) + w2 * bflo(c.w), w0 * bfhi(a.w) + w1 * bfhi(b.w) + w2 * bfhi(c.w));
        *(v4u*)(ATT + (size_t)t * 512 + hh * 128 + ch * 8) = o;
    }
}

constexpr int SCH = 128, NCH = M / SCH;
struct SsmLane { float ar, ai; float bbr[16], bbi[16]; };
__device__ __forceinline__ void ssm_params(const Ptrs& P, int g, int p, SsmLane& L) {
    const float dt = expf(P.in[7][g]);
    const float lr = P.in[5][g * 64 + p], li = P.in[6][g * 64 + p];
    const float mag = expf(lr * dt); float sn, cs; sincos_acc(li * dt, sn, cs);
    L.ar = mag * cs; L.ai = mag * sn;
    const float nr = L.ar - 1.0f, ni = L.ai, den = lr * lr + li * li;
    const float zr = (nr * lr + ni * li) / den, zi = (ni * lr - nr * li) / den;
    const f32x4* br = (const f32x4*)(P.in[8] + (size_t)(g * 64 + p) * 16); const f32x4* bi = (const f32x4*)(P.in[9] + (size_t)(g * 64 + p) * 16);
#pragma unroll
    for (int q = 0; q < 4; ++q) { const f32x4 a = br[q], b = bi[q];
#pragma unroll
        for (int j = 0; j < 4; ++j) { L.bbr[4 * q + j] = zr * a[j] - zi * b[j]; L.bbi[4 * q + j] = zr * b[j] + zi * a[j]; } }
}
__device__ __forceinline__ void ssm_load_u(const float* U, int t0, int g, LAS float* ul, int lane) {
#pragma unroll
    for (int it = 0; it < 8; ++it) { const int row = it * 16 + (lane >> 2), q = lane & 3;
        const f32x4 v = *(const f32x4*)(U + (size_t)(t0 + row) * SSMW + g * 16 + 4 * q); *(LAS f32x4*)(ul + row * 16 + 4 * q) = v; }
    LDS_WAIT();
}
__device__ __forceinline__ void ssm_step(const SsmLane& L, const LAS float* urow, float& hr, float& hi) {
    const LAS f32x4* u4 = (const LAS f32x4*)urow;
    float bre = 0.f, bim = 0.f;
#pragma unroll
    for (int q = 0; q < 4; ++q) { const f32x4 u = u4[q];
#pragma unroll
        for (int j = 0; j < 4; ++j) { bre = fmaf(u[j], L.bbr[4 * q + j], bre); bim = fmaf(u[j], L.bbi[4 * q + j], bim); } }
    const float nr = fmaf(L.ar, hr, fmaf(-L.ai, hi, bre)), ni = fmaf(L.ar, hi, fmaf(L.ai, hr, bim));
    hr = nr; hi = ni;
}
__device__ __forceinline__ void ssm_pass1(const Ptrs& P, const float* U, f32x2* E, LAS unsigned char* lds, int gw, int NGW, int wave, int lane) {
    LAS float* ul = (LAS float*)(lds + wave * 16384);
    for (int unit = gw; unit < NCH * 32; unit += NGW) {
        const int g = unit & 31, c = unit >> 5;
        SsmLane L; ssm_params(P, g, lane, L);
        ssm_load_u(U, c * SCH, g, ul, lane);
        float hr = 0.f, hi = 0.f;
#pragma unroll 4
        for (int t = 0; t < SCH; ++t) ssm_step(L, ul + t * 16, hr, hi);
        E[(size_t)(c * 32 + g) * 64 + lane] = (f32x2){hr, hi};
        LDS_WAIT();
    }
}
__device__ __forceinline__ float gelu_tanh(float x) {
    const float z = 0.7978845608028654f * (x + 0.044715f * x * x * x);
    const float e = __expf(2.0f * z);
    const float th = 1.0f - 2.0f * __builtin_amdgcn_rcpf(1.0f + e);
    return 0.5f * x * (1.0f + th);
}
__device__ __forceinline__ void ssm_pass3(const Ptrs& P, const float* U, const f32x2* E, bf16* Y, LAS unsigned char* lds, int gw, int NGW, int wave, int lane) {
    LAS float* ul = (LAS float*)(lds + wave * 16384);
    LAS unsigned char* hl = lds + wave * 16384 + 8192;
    const int l16 = lane & 15, g4 = lane >> 4;
    for (int unit = gw; unit < NCH * 32; unit += NGW) {
        const int g = unit & 31, c = unit >> 5;
        SsmLane L; ssm_params(P, g, lane, L);
        bf16x8 cf[4];
#pragma unroll
        for (int ks = 0; ks < 4; ++ks) {
            const f32x4 cr = *(const f32x4*)(P.in[10] + (size_t)(g * 16 + l16) * 64 + 16 * ks + 4 * g4), ci = *(const f32x4*)(P.in[11] + (size_t)(g * 16 + l16) * 64 + 16 * ks + 4 * g4);
            v4u w; w.x = pkbf(cr[0], -ci[0]); w.y = pkbf(cr[1], -ci[1]); w.z = pkbf(cr[2], -ci[2]); w.w = pkbf(cr[3], -ci[3]);
            cf[ks] = __builtin_bit_cast(bf16x8, w);
        }
        const f32x4 dsk = *(const f32x4*)(P.in[12] + g * 16 + 4 * g4);
        ssm_load_u(U, c * SCH, g, ul, lane);
        float pr = L.ar, pi = L.ai;
#pragma unroll
        for (int s = 0; s < 7; ++s) { const float a = pr * pr - pi * pi, b = 2.0f * pr * pi; pr = a; pi = b; }
        float hr = 0.f, hi = 0.f;
        { int cc = 0;
          for (; cc + 8 <= c; cc += 8) { f32x2 e[8];
#pragma unroll
              for (int j = 0; j < 8; ++j) e[j] = E[(size_t)((cc + j) * 32 + g) * 64 + lane];
#pragma unroll
              for (int j = 0; j < 8; ++j) { const float nr = fmaf(pr, hr, fmaf(-pi, hi, e[j].x)), ni = fmaf(pr, hi, fmaf(pi, hr, e[j].y)); hr = nr; hi = ni; } }
          for (; cc < c; ++cc) { const f32x2 e = E[(size_t)(cc * 32 + g) * 64 + lane]; const float nr = fmaf(pr, hr, fmaf(-pi, hi, e.x)), ni = fmaf(pr, hi, fmaf(pi, hr, e.y)); hr = nr; hi = ni; } }
        for (int tb = 0; tb < SCH; tb += 16) {
#pragma unroll 4
            for (int tt = 0; tt < 16; ++tt) { ssm_step(L, ul + (tb + tt) * 16, hr, hi); *(LAS unsigned*)(hl + tt * 272 + lane * 4) = pkbf(hr, hi); }
            LDS_WAIT();
            f32x4 acc = {0.f, 0.f, 0.f, 0.f};
#pragma unroll
            for (int ks = 0; ks < 4; ++ks) { const bf16x8 hb = *(const LAS bf16x8*)(hl + l16 * 272 + 64 * ks + 16 * g4); acc = __builtin_amdgcn_mfma_f32_16x16x32_bf16(cf[ks], hb, acc, 0, 0, 0); }
            const f32x4 uu = *(const LAS f32x4*)(ul + (tb + l16) * 16 + 4 * g4);
            v2u w; w.x = pkbf(gelu_tanh(acc[0] + dsk[0] * uu[0]), gelu_tanh(acc[1] + dsk[1] * uu[1])); w.y = pkbf(gelu_tanh(acc[2] + dsk[2] * uu[2]), gelu_tanh(acc[3] + dsk[3] * uu[3]));
            *(v2u*)(Y + (size_t)(c * SCH + tb + l16) * SSMW + g * 16 + 4 * g4) = w;
            LDS_WAIT();
        }
    }
}

#define RLX_AGENT __ATOMIC_RELAXED, __HIP_MEMORY_SCOPE_AGENT
#define XB_TMO      128
#define XB_XCNT(j)  (256  + 64 * (j))
#define XB_XSUB(j)  (1280 + 64 * (j))
#define XB_XGEN(j)  (2304 + 64 * (j))
#define XB_TOP      3328
#define XB_TOPGEN   3392
#define XCD_BAR_WORDS 3456
#define XB_SPIN_CAP (1u << 18)

__device__ __forceinline__ unsigned xb_ld(unsigned* p)              { return __hip_atomic_load(p, __ATOMIC_RELAXED, __HIP_MEMORY_SCOPE_AGENT); }
__device__ __forceinline__ unsigned xb_add(unsigned* p, unsigned v) { return __hip_atomic_fetch_add(p, v, __ATOMIC_RELAXED, __HIP_MEMORY_SCOPE_AGENT); }
__device__ __forceinline__ unsigned xb_xcc_id() { return (unsigned)__builtin_amdgcn_s_getreg((3 << 11) | 20) & 0xFu; }
#define XB_SPIN(cond, bar) do { unsigned _sp = 0; while (cond) { __builtin_amdgcn_s_sleep(1); \
    if ((++_sp & 255u) == 0u) { if (xb_ld(&(bar)[XB_TMO])) break; if (_sp > XB_SPIN_CAP) { atomicAdd(&(bar)[XB_TMO], 1u); break; } } } } while (0)

struct XcdBarrier {
    unsigned* bar; unsigned x;
    volatile LAS unsigned* st;
};

__device__ __forceinline__ XcdBarrier xcd_barrier_post(unsigned* bar, volatile LAS unsigned* st) {
    XcdBarrier b; b.bar = bar; b.x = xb_xcc_id(); b.st = st;
    if (threadIdx.x == 0) (void)xb_add(&bar[XB_XCNT(b.x)], 1u);
    return b;
}
__device__ __forceinline__ void xcd_barrier_complete(unsigned* bar, unsigned x, unsigned& nloc, unsigned& nx) {
    const unsigned G = gridDim.x * gridDim.y * gridDim.z;
    unsigned sum, cnt, mine, sp = 0u;
    for (;;) {
        sum = 0u; cnt = 0u; mine = 0u;
#pragma unroll
        for (unsigned j = 0; j < 16; ++j) { const unsigned c = xb_ld(&bar[XB_XCNT(j)]); sum += c; cnt += (c > 0u) ? 1u : 0u; mine = (j == x) ? c : mine; }
        if (sum == G) break;
        __builtin_amdgcn_s_sleep(1);
        if ((++sp & 255u) == 0u) { if (xb_ld(&bar[XB_TMO])) break; if (sp > XB_SPIN_CAP) { atomicAdd(&bar[XB_TMO], 1u); break; } }
    }
    nloc = mine > 0u ? mine : 1u; nx = cnt > 0u ? cnt : 1u;
}

__device__ __forceinline__ void xcd_barrier(const XcdBarrier& b) {
    asm volatile("s_waitcnt vmcnt(0)" ::: "memory");
    __syncthreads();
    if (threadIdx.x == 0) {
        unsigned* bar = b.bar;
        __builtin_amdgcn_s_waitcnt(0);
        unsigned nloc = b.st[0], nx = b.st[1];
        if (nloc == 0u) { xcd_barrier_complete(bar, b.x, nloc, nx); b.st[0] = nloc; b.st[1] = nx; }
        const unsigned old = xb_add(&bar[XB_XSUB(b.x)], 1u);
        const unsigned gen = old / nloc;
        if (old + 1u == (gen + 1u) * nloc) {
            __builtin_amdgcn_fence(__ATOMIC_RELEASE, "agent");
            asm volatile("s_waitcnt vmcnt(0)" ::: "memory");
            const unsigned og = xb_add(&bar[XB_TOP], 1u);
            const unsigned tg = og / nx;
            if (og + 1u == (tg + 1u) * nx) xb_add(&bar[XB_TOPGEN], 1u);
            else XB_SPIN(xb_ld(&bar[XB_TOPGEN]) == tg, bar);
            __builtin_amdgcn_fence(__ATOMIC_ACQUIRE, "agent");
            xb_add(&bar[XB_XGEN(b.x)], 1u);
            asm volatile("s_waitcnt vmcnt(0)" ::: "memory");
        } else {
            XB_SPIN(xb_ld(&bar[XB_XGEN(b.x)]) == gen, bar);
            __builtin_amdgcn_fence(__ATOMIC_ACQUIRE, "agent");
            asm volatile("s_waitcnt vmcnt(0)" ::: "memory");
        }
    }
    __syncthreads();
}

constexpr size_t WS_BAR = 65536; constexpr int LDS_MISC_OFF = 143360;
__global__ void __launch_bounds__(NTHR, 2) mk_fwd(Args args) {
    extern __shared__ __attribute__((aligned(16))) unsigned char lds_raw[];
    LAS unsigned char* lds = (LAS unsigned char*)lds_raw;
    cg::grid_group grid = cg::this_grid();
    const int tid = threadIdx.x, lane = tid & 63, wave = __builtin_amdgcn_readfirstlane(tid >> 6);
    const int G = gridDim.x, bid = blockIdx.x;
    const int gw = bid * NWAVES + wave, NGW = G * NWAVES, gtid = bid * NTHR + tid, GT = G * NTHR;
    const Args& P = args;
    const int lo = args.ph_lo, hi = args.ph_hi;
    volatile LAS unsigned* MISC = (volatile LAS unsigned*)(lds + LDS_MISC_OFF);
    if (tid < 16) MISC[tid] = 0u;
    __syncthreads();
    XcdBarrier bar; bar.bar = (unsigned*)(args.ws + WS_BAR); bar.x = 0; bar.st = nullptr;
    if (hi - lo > 1) bar = xcd_barrier_post((unsigned*)(args.ws + WS_BAR), MISC + 8);
#ifndef PHMASK
#define PHMASK 0xFFFF
#endif
#define IN(k) (((PHMASK >> (k)) & 1) && lo <= (k) && (k) < hi)
#define SEAM(k) do { if (IN(k) && IN((k) + 1)) { if ((k) == 0) grid.sync(); else xcd_barrier(bar); } } while (0)
#define Qb ((bf16*)(args.ws + WS_Q))
#define Kb ((bf16*)(args.ws + WS_K))
#define Vb ((bf16*)(args.ws + WS_V))
#define GA ((bf16*)(args.ws + WS_GA))
#define GS ((bf16*)(args.ws + WS_GS))
#define Ub ((float*)((unsigned char*)args.out + DO_U))
#define XB ((bf16*)((unsigned char*)args.out + DO_XB))
#define ATT ((bf16*)((unsigned char*)args.out + DO_ATT))
#define Yb ((bf16*)((unsigned char*)args.out + DO_Y))
#define LSE ((float*)(args.ws + WS_LSE))
#define SE ((f32x2*)(args.ws + WS_SSME))
#define MRG ((bf16*)(args.ws + WS_MRG))
#define PB ((bf16*)(args.ws + WS_PB))
#define PP ((bf16*)(args.ws + WS_PP))
#define H1B ((bf16*)(args.ws + WS_H1B))
#define ACT ((bf16*)(args.ws + WS_ACT))
#define H2B ((bf16*)(args.ws + WS_H2B))
#define ssq1 ((float*)(args.ws + WS_SSQ1))
#define ssq3 ((float*)(args.ws + WS_SSQ3))
    if (IN(0)) { p0_prologue(P, lds, gw, NGW, wave, lane, gtid, GT); }
    SEAM(0);
    if (IN(1)) {
        pg8::Gemm g{XB, (const bf16*)(args.ws + WS_WIN), M, INW, D}; pg8::StaticOrder S; S.init(M, INW, G, bid);
        EpiIn E{Qb, Kb, Vb, GA, GS, Ub, (const float*)(args.ws + WS_RS1), (const f32x4*)(args.ws + WS_ROPE)};
        pg8::gemm_phase<EpiIn, pg8::StaticOrder, true, true>(lds, g, S, E);
    }
    SEAM(1);
    if (IN(2)) {
        for (int unit = bid; unit < 1536; unit += G) attn_unit(lds, Qb, Kb, Vb, LSE, unit, tid, wave, lane);
        __syncthreads();
        ssm_pass1(P, Ub, SE, lds, gw, NGW, wave, lane);
    }
    SEAM(2);
    if (IN(3)) {
        merge_rows(Qb, LSE, ATT, gw, NGW, lane);
        ssm_pass3(P, Ub, SE, Yb, lds, gw, NGW, wave, lane);
        __syncthreads();
    }
    SEAM(3);
    if (IN(4)) {
        for (int m = gw; m < M; m += NGW) { const f32x4 v = *((const f32x4*)(P.in[1] + (size_t)m * PLE) + lane); v2u w; w.x = pkbf(v.x, v.y); w.y = pkbf(v.z, v.w); *((v2u*)(PB + (size_t)m * PLE) + lane) = w; }
        asm volatile("s_waitcnt vmcnt(0)" ::: "memory"); __syncthreads();
        pg8::Gemm g{Yb, (const bf16*)(args.ws + WS_WGLU), M, 2048, 512}; pg8::StaticOrder S; S.init(M, 2048, G, bid);
        EpiGlu E{GS, MRG};
        pg8::gemm_phase<EpiGlu, pg8::StaticOrder, true, true>(lds, g, S, E);
    }
    SEAM(4);
    if (IN(5)) {
        pg8::Gemm g{ATT, (const bf16*)(args.ws + WS_WPROJ), M, D, 512}; pg8::StaticOrder S; S.init(M, D, G, bid);
        EpiProj E{GA, MRG};
        pg8::gemm_phase<EpiProj, pg8::StaticOrder, true, true>(lds, g, S, E);
    }
    SEAM(5);
    if (IN(6)) {
        {
            pg8::Gemm g{MRG, (const bf16*)(args.ws + WS_WOUT), M, D, D}; pg8::StaticOrder S; S.init(M, D, G, bid);
            EpiRes<0, true, true> E{P.in[0], P.out, H1B, ssq1, nullptr};
            pg8::gemm_phase<EpiRes<0, true, true>, pg8::StaticOrder, true, true>(lds, g, S, E);
        }
    }
    if (IN(7)) {
        {
            int kple = PLE; asm volatile("" : "+s"(kple));
            pg8::Gemm g{PB, (const bf16*)(args.ws + WS_WPLEP), M, D, kple}; pg8::StaticOrder S; S.init(M, D, G, bid);
            EpiStore E{PP, D};
            pg8::gemm_phase<EpiStore, pg8::StaticOrder, true, true>(lds, g, S, E);
        }
    }
    SEAM(7);
    if (IN(8)) {
        pg8::Gemm g{H1B, (const bf16*)(args.ws + WS_WGU), M, 2 * DFF, D}; pg8::StaticOrder S; S.init(M, 2 * DFF, G, bid);
        EpiSwiglu E{ssq1, ACT};
        pg8::gemm_phase<EpiSwiglu, pg8::StaticOrder, true, true>(lds, g, S, E);
    }
    SEAM(8);
    if (IN(9)) {
        pg8::Gemm g{ACT, (const bf16*)(args.ws + WS_WDOWN), M, D, DFF}; pg8::StaticOrder S; S.init(M, D, G, bid);
        EpiRes<0, true, false> E{P.out, P.out, H2B, nullptr, nullptr};
        pg8::gemm_phase<EpiRes<0, true, false>, pg8::StaticOrder, true, true>(lds, g, S, E);
    }
    SEAM(9);
    if (IN(10)) {
        pg8::Gemm g{H2B, (const bf16*)(args.ws + WS_WPLEG), M, D, D}; pg8::StaticOrder S; S.init(M, D, G, bid);
        EpiRes<1, false, true> E{P.out, P.out, nullptr, ssq3, PP};
        pg8::gemm_phase<EpiRes<1, false, true>, pg8::StaticOrder, true, true>(lds, g, S, E);
    }
    SEAM(10);
    if (IN(11)) {
        const f32x4* gf = (const f32x4*)P.in[23];
        for (int m = gw; m < M; m += NGW) {
            const f32x4* sp = (const f32x4*)(ssq3 + (size_t)m * 16);
            const f32x4 s0 = sp[0], s1 = sp[1], s2 = sp[2], s3 = sp[3];
            const float tot = ((s0.x + s0.y) + (s0.z + s0.w)) + ((s1.x + s1.y) + (s1.z + s1.w)) + ((s2.x + s2.y) + (s2.z + s2.w)) + ((s3.x + s3.y) + (s3.z + s3.w));
            const float rs = 1.0f / sqrtf(tot * (1.0f / D) + EPS);
            f32x4* o = (f32x4*)(P.out + (size_t)m * D) + lane;
#pragma unroll
            for (int j = 0; j < 4; ++j) { const f32x4 h = o[64 * j]; o[64 * j] = h * rs * gf[64 * j + lane]; }
        }
    }
#undef IN
#undef SEAM
}

extern "C" void kernel_launch(void* const* d_in, const int* in_sizes, int n_in, void* d_out, int out_size, void* d_ws, size_t ws_size, hipStream_t stream) {
    static int grid = 0;
    if (grid == 0) {
        if (n_in != 24 || out_size != M * D || ws_size < WS_END) { fprintf(stderr, "kernel_launch: unexpected shapes (n_in %d out %d ws %zu)\n", n_in, out_size, ws_size); grid = -1; return; }
        int dev = 0, cus = 0, per_cu = 0;
        hipGetDevice(&dev); hipDeviceGetAttribute(&cus, hipDeviceAttributeMultiprocessorCount, dev);
        hipFuncSetAttribute((const void*)mk_fwd, hipFuncAttributeMaxDynamicSharedMemorySize, LDS_BYTES);
        if (hipOccupancyMaxActiveBlocksPerMultiprocessor(&per_cu, (const void*)mk_fwd, NTHR, LDS_BYTES) != hipSuccess || per_cu < 1) per_cu = 1;
        (void)hipGetLastError();
        grid = cus * per_cu;
    }
    if (grid < 0) return;
    Args a{};
    for (int i = 0; i < 24; ++i) a.in[i] = (const float*)d_in[i];
    a.out = (float*)d_out; a.ws = (unsigned char*)d_ws;
#if MK_LAUNCHES == 1
    (void)hipMemsetAsync((unsigned char*)d_ws + WS_BAR, 0, 16384, stream);
    a.ph_lo = 0; a.ph_hi = NPH;
    void* kargs[] = {&a};
    hipError_t e = hipLaunchCooperativeKernel((const void*)mk_fwd, dim3(grid), dim3(NTHR), kargs, LDS_BYTES, stream);
    if (e != hipSuccess) fprintf(stderr, "cooperative launch failed: %s (grid %d)\n", hipGetErrorString(e), grid);
#else
    for (int ph = 0; ph < NPH; ++ph) { a.ph_lo = ph; a.ph_hi = ph + 1; hipLaunchKernelGGL(mk_fwd, dim3(grid), dim3(NTHR), LDS_BYTES, stream, a); }
#endif
}
```

```cpp
#include <hip/hip_runtime.h>
#include <hip/hip_cooperative_groups.h>
#include <cstdio>
#include <cstdint>
#include <cmath>
namespace cg = cooperative_groups;
namespace pg8 {
#define PG8_LAS __attribute__((address_space(3)))
typedef unsigned short bf16_t;
typedef short bf16x8 __attribute__((ext_vector_type(8)));
typedef float f32x4 __attribute__((ext_vector_type(4)));
typedef unsigned u32x4 __attribute__((ext_vector_type(4)));
constexpr int BM = 256, BK = 64, HALF = 128, HTB = HALF * BK * 2  , STAGE_BYTES = 8 * HTB, NXCD = 8, WGM = 8;

__host__ __device__ __forceinline__ int lds_byte(int r, int c) { const int st = (r >> 4) * 2 + (c >> 5), rr = r & 15, cc = c & 31, ob = rr * 64 + cc * 2; return st * 1024 + (ob ^ (((ob >> 9) & 1) << 5)); }
__host__ __device__ __forceinline__ void stage_rc(int b, int& R, int& C) { const int st = b / 1024, sb = b % 1024, swz = sb ^ (((sb >> 9) & 1) << 5); R = (st >> 1) * 16 + swz / 64; C = (st & 1) * 32 + (swz % 64) / 2; }
__host__ __device__ __forceinline__ int perm32(int rho) { const int n = rho >> 4, i = rho & 15; return 8 * (i >> 2) + 4 * n + (i & 3); }

struct Unit { int pm, pn; };
struct Gemm { const bf16_t* A; const bf16_t* Bt; int M, N, K; };

struct StaticOrder {
    int nM, nN, nwg, G, c;
    __host__ __device__ void init(int M, int N, int G_, int c_) { nM = M / BM; nN = N / BM; nwg = nM * nN; G = G_; c = c_; }
    __host__ __device__ bool next(int i, Unit& u) const {
        const long L = (long)i * G + c; if (L >= nwg) return false;
        int wgid = (int)L; { const int q = nwg / NXCD, r = nwg % NXCD, xcd = wgid % NXCD, off = wgid / NXCD; wgid = (xcd < r ? xcd * (q + 1) : r * (q + 1) + (xcd - r) * q) + off; }
        const int nig = WGM * nN, gid = wgid / nig, fm = gid * WGM, gsz = (nM - fm) < WGM ? (nM - fm) : WGM;
        u.pm = fm + ((wgid % nig) % gsz); u.pn = (wgid % nig) / gsz; return true;
    }
    __device__ __forceinline__ void a_ready(const Unit&) const {}
    __device__ __forceinline__ void done(const Unit&) const {}
};

__device__ __forceinline__ unsigned cvt_pk_bf16(float lo, float hi) { unsigned r; asm volatile("v_cvt_pk_bf16_f32 %0, %1, %2" : "=v"(r) : "v"(lo), "v"(hi)); return r; }
typedef float f32x2 __attribute__((ext_vector_type(2)));
template <class Epi, class Sched, bool ALIGN_EPI = false, bool SP2 = false>
__device__ __forceinline__ void gemm_phase(PG8_LAS unsigned char* lds, const Gemm g, const Sched& S, const Epi& E) {
    const int tid = threadIdx.x, wid = __builtin_amdgcn_readfirstlane(tid >> 6), lane = tid & 63, wr = wid >> 2, wc = wid & 3, fr = lane & 15, fq = lane >> 4;
    const int K = g.K, nt = K / BK;
    unsigned voffA[2], voffB[2];
#pragma unroll
    for (int i = 0; i < 2; ++i) { int R, C; stage_rc(tid * 16 + i * 8192, R, C); const int Rb = Epi::PERM ? ((R & ~31) + perm32(R & 31)) : R;
        voffA[i] = (unsigned)(R * K + C) * 2u; voffB[i] = (unsigned)(Rb * K + C) * 2u; }
    const size_t kstep = (size_t)(BK * 2);
    const size_t hstep = (size_t)HALF * K * 2;
    const size_t tstep = 2 * hstep;
    const unsigned ldsw = (unsigned)wid * 1024u;
    const int aoff = lds_byte(wr * 64 + fr, fq * 8), boff = lds_byte(wc * 32 + fr, fq * 8);
#define PG8_SA(b, h) (((b) * 2 + (h)) * HTB)
#define PG8_SB(b, h) ((4 + (b) * 2 + (h)) * HTB)
#define PG8_STAGE(bufoff, gbase, voff) do { _Pragma("unroll") for (int _i = 0; _i < 2; ++_i) \
        __builtin_amdgcn_global_load_lds((const unsigned*)((const char*)(gbase) + (voff)[_i]), (PG8_LAS unsigned*)(lds + (bufoff) + ldsw + _i * 8192), 16, 0, 0); } while (0)
#define PG8_LDA(dst, b, h) do { _Pragma("unroll") for (int m = 0; m < 4; ++m) _Pragma("unroll") for (int k = 0; k < 2; ++k) dst[m][k] = *(const PG8_LAS bf16x8*)(lds + PG8_SA(b, h) + aoff + m * 2048 + k * 1024); } while (0)
#define PG8_LDB(dst, b, h) do { _Pragma("unroll") for (int n = 0; n < 2; ++n) _Pragma("unroll") for (int k = 0; k < 2; ++k) dst[n][k] = *(const PG8_LAS bf16x8*)(lds + PG8_SB(b, h) + boff + n * 2048 + k * 1024); } while (0)
#define PG8_MMA(ai, bj, At, Bt) do { __builtin_amdgcn_s_setprio(1); _Pragma("unroll") for (int m = 0; m < 4; ++m) _Pragma("unroll") for (int n = 0; n < 2; ++n) _Pragma("unroll") for (int k = 0; k < 2; ++k) \
        acc[ai][bj][m][n] = __builtin_amdgcn_mfma_f32_16x16x32_bf16(Bt[n][k], At[m][k], acc[ai][bj][m][n], 0, 0, 0); __builtin_amdgcn_s_setprio(0); } while (0)
#define PG8_WAIT_V(n) asm volatile("s_waitcnt vmcnt(" #n ")" ::: "memory")
#define PG8_WAIT_L(n) asm volatile("s_waitcnt lgkmcnt(" #n ")" ::: "memory")
#define PG8_BAR __builtin_amdgcn_s_barrier()
#define PG8_SCHED __builtin_amdgcn_sched_barrier(0)
    Unit cur, nxt; int ui = 0;
    if (!S.next(0, cur)) return;
    f32x4 acc[2][2][4][2];
#pragma unroll
    for (int a = 0; a < 2; ++a)
#pragma unroll
        for (int b = 0; b < 2; ++b)
#pragma unroll
            for (int m = 0; m < 4; ++m)
#pragma unroll
                for (int n = 0; n < 2; ++n) acc[a][b][m][n] = (f32x4){0.f, 0.f, 0.f, 0.f};
    bf16x8 At[4][2], B0[2][2], B1[2][2];
    const char* cA = (const char*)g.A + (size_t)cur.pm * tstep; const char* cB = (const char*)g.Bt + (size_t)cur.pn * tstep;
    S.a_ready(cur);
    if constexpr (SP2) {
        PG8_STAGE(PG8_SB(0, 0), cB, voffB); PG8_STAGE(PG8_SB(0, 1), cB + hstep, voffB); PG8_STAGE(PG8_SA(0, 0), cA, voffA); PG8_STAGE(PG8_SA(0, 1), cA + hstep, voffA);
        if (wr == 1) PG8_BAR;
        PG8_WAIT_V(2); PG8_BAR;
        PG8_STAGE(PG8_SB(1, 0), cB + kstep, voffB); PG8_STAGE(PG8_SA(1, 0), cA + kstep, voffA); PG8_STAGE(PG8_SB(1, 1), cB + hstep + kstep, voffB);
        PG8_WAIT_V(6); PG8_BAR;
    } else {
        PG8_STAGE(PG8_SB(0, 0), cB, voffB); PG8_STAGE(PG8_SA(0, 0), cA, voffA); PG8_STAGE(PG8_SB(0, 1), cB + hstep, voffB); PG8_STAGE(PG8_SA(0, 1), cA + hstep, voffA);
        if (wr == 1) PG8_BAR;
        PG8_WAIT_V(4); PG8_BAR;
        PG8_STAGE(PG8_SB(1, 0), cB + kstep, voffB); PG8_STAGE(PG8_SA(1, 0), cA + kstep, voffA); PG8_STAGE(PG8_SB(1, 1), cB + hstep + kstep, voffB);
        PG8_WAIT_V(6); PG8_BAR;
    }
    for (;;) {
        const bool has_next = S.next(ui + 1, nxt);
        const char* nA = has_next ? (const char*)g.A + (size_t)nxt.pm * tstep : cA; const char* nB = has_next ? (const char*)g.Bt + (size_t)nxt.pn * tstep : cB;
        for (int t = 0; t < nt; t += 2) {
            const bool last = (t == nt - 2);
            const char* a1 = cA + (size_t)(t + 1) * kstep;
            const char* a2 = last ? nA : cA + (size_t)(t + 2) * kstep; const char* b2 = last ? nB : cB + (size_t)(t + 2) * kstep;
            const char* a3 = a2 + kstep; const char* b3 = b2 + kstep;
            if (last && has_next) S.a_ready(nxt);
            if constexpr (SP2) {
            PG8_LDB(B0, 0, 0); PG8_LDB(B1, 0, 1); PG8_SCHED; PG8_LDA(At, 0, 0); PG8_STAGE(PG8_SA(1, 1), a1 + hstep, voffA);
            PG8_WAIT_V(8); PG8_WAIT_L(0); PG8_BAR; PG8_MMA(0, 0, At, B0); PG8_MMA(0, 1, At, B1); PG8_BAR; PG8_SCHED;
            PG8_LDA(At, 0, 1); PG8_STAGE(PG8_SB(0, 0), b2, voffB); PG8_STAGE(PG8_SB(0, 1), b2 + hstep, voffB); PG8_STAGE(PG8_SA(0, 0), a2, voffA);
            PG8_WAIT_V(8); PG8_WAIT_L(0); PG8_BAR; PG8_MMA(1, 0, At, B0); PG8_MMA(1, 1, At, B1); PG8_BAR; PG8_SCHED;
            PG8_LDB(B0, 1, 0); PG8_LDB(B1, 1, 1); PG8_SCHED; PG8_LDA(At, 1, 0); PG8_STAGE(PG8_SA(0, 1), a2 + hstep, voffA);
            PG8_WAIT_V(8); PG8_WAIT_L(0); PG8_BAR; PG8_MMA(0, 0, At, B0); PG8_MMA(0, 1, At, B1); PG8_BAR; PG8_SCHED;
            PG8_LDA(At, 1, 1); PG8_STAGE(PG8_SB(1, 0), b3, voffB); PG8_STAGE(PG8_SB(1, 1), b3 + hstep, voffB); PG8_STAGE(PG8_SA(1, 0), a3, voffA);
            PG8_WAIT_V(8); PG8_WAIT_L(0); PG8_BAR; PG8_MMA(1, 0, At, B0); PG8_MMA(1, 1, At, B1); PG8_BAR; PG8_SCHED;
            } else {
            PG8_LDB(B0, 0, 0); PG8_SCHED; PG8_LDA(At, 0, 0); PG8_STAGE(PG8_SA(1, 1), a1 + hstep, voffA);
            PG8_WAIT_L(8); PG8_BAR; PG8_WAIT_L(0); PG8_MMA(0, 0, At, B0); PG8_BAR; PG8_SCHED;
            PG8_LDB(B1, 0, 1); PG8_STAGE(PG8_SB(0, 0), b2, voffB);
            PG8_BAR; PG8_WAIT_L(0); PG8_MMA(0, 1, At, B1); PG8_BAR;
            PG8_LDA(At, 0, 1); PG8_STAGE(PG8_SA(0, 0), a2, voffA);
            PG8_BAR; PG8_WAIT_L(0); PG8_MMA(1, 0, At, B0); PG8_BAR; PG8_SCHED;
            PG8_STAGE(PG8_SB(0, 1), b2 + hstep, voffB);
            PG8_WAIT_V(6); PG8_BAR; PG8_MMA(1, 1, At, B1); PG8_BAR;
            PG8_LDB(B0, 1, 0); PG8_SCHED; PG8_LDA(At, 1, 0); PG8_STAGE(PG8_SA(0, 1), a2 + hstep, voffA);
            PG8_WAIT_L(8); PG8_BAR; PG8_WAIT_L(0); PG8_MMA(0, 0, At, B0); PG8_BAR; PG8_SCHED;
            PG8_LDB(B1, 1, 1); PG8_STAGE(PG8_SB(1, 0), b3, voffB);
            PG8_BAR; PG8_WAIT_L(0); PG8_MMA(0, 1, At, B1); PG8_BAR;
            PG8_LDA(At, 1, 1); PG8_STAGE(PG8_SA(1, 0), a3, voffA);
            PG8_BAR; PG8_WAIT_L(0); PG8_MMA(1, 0, At, B0); PG8_BAR; PG8_SCHED;
            PG8_STAGE(PG8_SB(1, 1), b3 + hstep, voffB);
            PG8_WAIT_V(6); PG8_BAR; PG8_MMA(1, 1, At, B1); PG8_BAR;
            }
        }
        if constexpr (ALIGN_EPI) { if (wr == 0) PG8_BAR; }
        if constexpr (!Epi::AFTER_DRAIN) { E(acc, cur, wr, wc, fr, fq); S.done(cur); }
        if (!has_next) break;
#pragma unroll
        for (int a = 0; a < 2; ++a)
#pragma unroll
            for (int b = 0; b < 2; ++b)
#pragma unroll
                for (int m = 0; m < 4; ++m)
#pragma unroll
                    for (int n = 0; n < 2; ++n) acc[a][b][m][n] = (f32x4){0.f, 0.f, 0.f, 0.f};
        cur = nxt; cA = nA; cB = nB; ++ui;
        if constexpr (ALIGN_EPI) { if (wr == 1) PG8_BAR; }
    }
    PG8_WAIT_V(0);
    if constexpr (!ALIGN_EPI) { if (wr == 0) PG8_BAR; }
    PG8_BAR;
    if constexpr (Epi::AFTER_DRAIN) { E.fused(acc, cur, wr, wc, fr, fq, lds, wid, lane); S.done(cur); }
#undef PG8_SA
#undef PG8_SB
#undef PG8_STAGE
#undef PG8_LDA
#undef PG8_LDB
#undef PG8_MMA
#undef PG8_WAIT_V
#undef PG8_WAIT_L
#undef PG8_BAR
#undef PG8_SCHED
}
}

#ifndef MK_LAUNCHES
#define MK_LAUNCHES 1
#endif
#define GAS __attribute__((address_space(1)))
#define LAS __attribute__((address_space(3)))
typedef unsigned short bf16;
typedef unsigned v4u __attribute__((ext_vector_type(4)));
typedef unsigned v2u __attribute__((ext_vector_type(2)));
typedef float f32x4 __attribute__((ext_vector_type(4)));
typedef float f32x2 __attribute__((ext_vector_type(2)));
typedef short bf16x8 __attribute__((ext_vector_type(8)));
typedef short s16x4 __attribute__((ext_vector_type(4)));
#define LDS_WAIT() asm volatile("s_waitcnt lgkmcnt(0)" ::: "memory")

constexpr int NWAVES = 8, NTHR = 512;
constexpr int M = 16384, D = 1024, INW = 7168, QKW = 1536, SSMW = 512, DFF = 2816, PLE = 256;
constexpr int NPH = 12;
constexpr float EPS = 1e-6f;
constexpr float QSCALE = 0.08838834764831845f * 1.4426950408889634f;
constexpr size_t MiB = 1u << 20;
constexpr size_t WS_RS1 = 0, WS_SSQ1 = 1 * MiB, WS_SSQ3 = 2 * MiB, WS_ROPE = 3 * MiB, WS_LSE = 5 * MiB, WS_SSME = 6 * MiB;
constexpr size_t WS_WIN = 8 * MiB, WS_WPROJ = 22 * MiB, WS_WGLU = 23 * MiB, WS_WOUT = 25 * MiB, WS_WGU = 27 * MiB, WS_WDOWN = 38 * MiB, WS_WPLEG = 44 * MiB, WS_WPLEP = 46 * MiB;
constexpr size_t WS_Q = 48 * MiB, WS_K = 96 * MiB, WS_V = 144 * MiB, WS_GA = 192 * MiB, WS_GS = 224 * MiB, WS_END = 256 * MiB;
constexpr size_t WS_MRG = 48 * MiB, WS_PB = 80 * MiB, WS_PP = 192 * MiB, WS_H1B = 224 * MiB, WS_ACT = 48 * MiB, WS_H2B = 136 * MiB;
constexpr size_t DO_XB = 0, DO_ATT = 0, DO_Y = 16 * MiB, DO_U = 32 * MiB;
constexpr int LDS_BYTES = 147456;

typedef __bf16 bf16x2_t __attribute__((ext_vector_type(2)));
__device__ __forceinline__ unsigned pkbf(float lo, float hi) { const f32x2 v = {lo, hi}; const bf16x2_t b = __builtin_convertvector(v, bf16x2_t); return __builtin_bit_cast(unsigned, b); }
__device__ __forceinline__ float bflo(unsigned w) { return __uint_as_float(w << 16); }
__device__ __forceinline__ float bfhi(unsigned w) { return __uint_as_float(w & 0xffff0000u); }
__device__ __forceinline__ float sigmoidf_(float x) { return __builtin_amdgcn_rcpf(1.0f + __expf(-x)); }
__device__ __forceinline__ float wave_sum(float v) {
#pragma unroll
    for (int o = 1; o < 64; o <<= 1) v += __shfl_xor(v, o);
    return v;
}
__device__ __forceinline__ void sincos_acc(float xf, float& s, float& c) {
    const double x = (double)xf;
    const double n = __builtin_rint(x * 0.63661977236758134308);
    double r = __builtin_fma(-n, 1.57079632679489655800, x);
    r = __builtin_fma(-n, 6.12323399573676603587e-17, r);
    const double r2 = r * r;
    double sp = 2.7557319223985893e-06;
    sp = __builtin_fma(sp, r2, -1.9841269841269841e-04);
    sp = __builtin_fma(sp, r2, 8.3333333333333333e-03);
    sp = __builtin_fma(sp, r2, -1.6666666666666666e-01);
    const double sn = __builtin_fma(sp * r2, r, r);
    double cp = -2.7557319223985888e-07;
    cp = __builtin_fma(cp, r2, 2.4801587301587302e-05);
    cp = __builtin_fma(cp, r2, -1.3888888888888889e-03);
    cp = __builtin_fma(cp, r2, 4.1666666666666664e-02);
    cp = __builtin_fma(cp, r2, -0.5);
    const double cs = __builtin_fma(cp, r2, 1.0);
    const int q = ((int)n) & 3;
    const double ss = (q & 1) ? cs : sn, cc = (q & 1) ? sn : cs;
    s = (float)((q & 2) ? -ss : ss);
    c = (float)(((q + 1) & 2) ? -cc : cc);
}

__device__ __forceinline__ void tr_item(const float* W, int K, int N, bf16* WT, int ileave, const float* gk, LAS float* scr, int item, int lane) {
    const int nblk = N / 32, kb = item / nblk, nb = item % nblk, k0 = 64 * kb, n0 = 32 * nb;
#pragma unroll 8
    for (int i = 0; i < 32; ++i) { const int kk = 2 * i + (lane >> 5); float w = W[(size_t)(k0 + kk) * N + n0 + (lane & 31)]; if (gk) w *= gk[k0 + kk]; scr[kk * 33 + (lane & 31)] = w; }
    LDS_WAIT();
    const int c = lane & 7;
#pragma unroll
    for (int j = 0; j < 4; ++j) { const int n = (lane >> 3) + 8 * j; const LAS float* s = scr + (8 * c) * 33 + n;
        v4u o; o.x = pkbf(s[0 * 33], s[1 * 33]); o.y = pkbf(s[2 * 33], s[3 * 33]); o.z = pkbf(s[4 * 33], s[5 * 33]); o.w = pkbf(s[6 * 33], s[7 * 33]);
        const int nn = n0 + n; const int drow = ileave ? ((nn >> 7) * 256 + (ileave - 1) * 128 + (nn & 127)) : nn;
        *(v4u*)(WT + (size_t)drow * K + k0 + 8 * c) = o; }
    LDS_WAIT();
}

struct Args { const float* in[24]; float* out; unsigned char* ws; int ph_lo, ph_hi; };
typedef Args Ptrs;

__device__ __forceinline__ void p0_prologue(const Ptrs& P, LAS unsigned char* lds, int gw, int NGW, int wave, int lane, int gtid, int GT) {
    LAS float* scr = (LAS float*)(lds + wave * 16384);
    unsigned char* ws = P.ws;
    constexpr int I_IN = (D / 64) * (INW / 32), I_PROJ = (512 / 64) * (D / 32), I_GLU = I_PROJ, I_OUT = (D / 64) * (D / 32), I_G = (D / 64) * (DFF / 32), I_DN = (DFF / 64) * (D / 32),
                  I_PG = I_OUT, I_PP = (PLE / 64) * (D / 32);
    constexpr int NITEMS = I_IN + I_PROJ + 2 * I_GLU + I_OUT + 2 * I_G + I_DN + I_PG + I_PP;
    for (int it = gw; it < NITEMS; it += NGW) {
        int r = it;
        if (r < I_IN) { tr_item(P.in[4], D, INW, (bf16*)(ws + WS_WIN), 0, P.in[3], scr, r, lane); continue; } r -= I_IN;
        if (r < I_PROJ) { tr_item(P.in[13], 512, D, (bf16*)(ws + WS_WPROJ), 0, nullptr, scr, r, lane); continue; } r -= I_PROJ;
        if (r < I_GLU) { tr_item(P.in[14], 512, D, (bf16*)(ws + WS_WGLU), 1, nullptr, scr, r, lane); continue; } r -= I_GLU;
        if (r < I_GLU) { tr_item(P.in[15], 512, D, (bf16*)(ws + WS_WGLU), 2, nullptr, scr, r, lane); continue; } r -= I_GLU;
        if (r < I_OUT) { tr_item(P.in[16], D, D, (bf16*)(ws + WS_WOUT), 0, nullptr, scr, r, lane); continue; } r -= I_OUT;
        if (r < I_G) { tr_item(P.in[18], D, DFF, (bf16*)(ws + WS_WGU), 1, P.in[17], scr, r, lane); continue; } r -= I_G;
        if (r < I_G) { tr_item(P.in[19], D, DFF, (bf16*)(ws + WS_WGU), 2, P.in[17], scr, r, lane); continue; } r -= I_G;
        if (r < I_DN) { tr_item(P.in[20], DFF, D, (bf16*)(ws + WS_WDOWN), 0, nullptr, scr, r, lane); continue; } r -= I_DN;
        if (r < I_PG) { tr_item(P.in[21], D, D, (bf16*)(ws + WS_WPLEG), 0, nullptr, scr, r, lane); continue; } r -= I_PG;
        tr_item(P.in[22], PLE, D, (bf16*)(ws + WS_WPLEP), 0, nullptr, scr, r, lane);
    }
    bf16* XB = (bf16*)((unsigned char*)P.out + DO_XB); float* rs1 = (float*)(ws + WS_RS1);
    for (int m = gw; m < M; m += NGW) {
        const f32x4* xr = (const f32x4*)(P.in[0] + (size_t)m * D) + lane;
        f32x4 v[4]; float s = 0.f;
#pragma unroll
        for (int j = 0; j < 4; ++j) { v[j] = xr[64 * j]; s += (v[j].x * v[j].x + v[j].y * v[j].y) + (v[j].z * v[j].z + v[j].w * v[j].w); }
        s = wave_sum(s);
        if (lane == 0) rs1[m] = 1.0f / sqrtf(s * (1.0f / D) + EPS);
        v2u* o8 = (v2u*)(XB + (size_t)m * D) + lane;
#pragma unroll
        for (int j = 0; j < 4; ++j) { v2u w; w.x = pkbf(v[j].x, v[j].y); w.y = pkbf(v[j].z, v[j].w); o8[64 * j] = w; }
    }
    const int* pos = (const int*)P.in[2]; f32x2* rope = (f32x2*)(ws + WS_ROPE);
    for (int e = gtid; e < M * 16; e += GT) {
        const int t = e >> 4, i = e & 15;
        float invf;
        switch (i) { case 0: invf = 1.0f; break; case 1: invf = 0.44036659598350525f; break; case 2: invf = 0.1939227432012558f; break; case 3: invf = 0.08539710193872452f; break;
            case 4: invf = 0.03760603070259094f; break; case 5: invf = 0.016560440883040428f; break; case 6: invf = 0.007292664609849453f; break; case 7: invf = 0.0032114461064338684f; break;
            case 8: invf = 0.0014142135623842478f; break; case 9: invf = 0.0006227724370546639f; break; case 10: invf = 0.00027424818836152554f; break; case 11: invf = 0.00012076973507646471f; break;
            case 12: invf = 5.3182957344688475e-05f; break; case 13: invf = 2.34199997066753e-05f; break; case 14: invf = 1.0313385246263351e-05f; break; default: invf = 4.541670477919979e-06f; break; }
        const float ang = (float)pos[t] * invf; float s, c; sincos_acc(ang, s, c);
        rope[e] = (f32x2){c, s};
    }
}

struct EpiIn {
    static constexpr bool PERM = false, AFTER_DRAIN = false;
    bf16 *Q, *K, *V, *GA, *GS; float* U; const float* rs1; const f32x4* rope;
    __device__ __forceinline__ void operator()(const f32x4 (&acc)[2][2][4][2], const pg8::Unit& u, int wr, int wc, int fr, int fq) const {
        const int pn = u.pn, row0 = u.pm * 256 + wr * 64 + fr, cl = wc * 32 + 4 * fq;
        if (pn < 12) {
            bf16* dst = pn < 6 ? Q : K; const int ct = (pn < 6 ? pn : pn - 6) * 256; const float qs = pn < 6 ? QSCALE : 1.0f;
#pragma unroll
            for (int ai = 0; ai < 2; ++ai)
#pragma unroll
                for (int m = 0; m < 4; ++m) {
                    const int row = row0 + ai * 128 + m * 16; const float rs = rs1[row] * qs;
                    f32x4 ca = {1.f, 0.f, 1.f, 0.f}, cb = {1.f, 0.f, 1.f, 0.f};
                    if (wc == 0) { ca = rope[(size_t)row * 8 + 2 * fq]; cb = rope[(size_t)row * 8 + 2 * fq + 1]; }
                    const float cs[4] = {ca.x, ca.z, cb.x, cb.z}, sn[4] = {ca.y, ca.w, cb.y, cb.w};
#pragma unroll
                    for (int bj = 0; bj < 2; ++bj) {
                        f32x4 v0 = acc[ai][bj][m][0] * rs, v1 = acc[ai][bj][m][1] * rs;
                        if (wc == 0) {
                            f32x4 o0, o1;
#pragma unroll
                            for (int j = 0; j < 4; ++j) { o0[j] = v0[j] * cs[j] - v1[j] * sn[j]; o1[j] = v1[j] * cs[j] + v0[j] * sn[j]; }
                            v0 = o0; v1 = o1;
                        }
                        bf16* p = dst + (size_t)row * QKW + ct + bj * 128 + cl;
                        v2u w0, w1; w0.x = pkbf(v0[0], v0[1]); w0.y = pkbf(v0[2], v0[3]); w1.x = pkbf(v1[0], v1[1]); w1.y = pkbf(v1[2], v1[3]);
                        *(v2u*)p = w0; *(v2u*)(p + 16) = w1;
                    }
                }
        } else if (pn < 18) {
            const int ct = (pn - 12) * 256;
#pragma unroll
            for (int ai = 0; ai < 2; ++ai)
#pragma unroll
                for (int m = 0; m < 4; ++m) {
                    const int row = row0 + ai * 128 + m * 16; const float rs = rs1[row];
#pragma unroll
                    for (int bj = 0; bj < 2; ++bj) {
                        const f32x4 v0 = acc[ai][bj][m][0] * rs, v1 = acc[ai][bj][m][1] * rs;
                        bf16* p = V + (size_t)row * QKW + ct + bj * 128 + cl;
                        v2u w0, w1; w0.x = pkbf(v0[0], v0[1]); w0.y = pkbf(v0[2], v0[3]); w1.x = pkbf(v1[0], v1[1]); w1.y = pkbf(v1[2], v1[3]);
                        *(v2u*)p = w0; *(v2u*)(p + 16) = w1;
                    }
                }
        } else if (pn < 20) {
            const int ct = (pn - 18) * 256;
#pragma unroll
            for (int ai = 0; ai < 2; ++ai)
#pragma unroll
                for (int m = 0; m < 4; ++m) {
                    const int row = row0 + ai * 128 + m * 16; const float rs = rs1[row];
#pragma unroll
                    for (int bj = 0; bj < 2; ++bj) {
                        float* p = U + (size_t)row * SSMW + ct + bj * 128 + cl;
                        *(f32x4*)p = acc[ai][bj][m][0] * rs; *(f32x4*)(p + 16) = acc[ai][bj][m][1] * rs;
                    }
                }
        } else {
            bf16* dst = pn < 24 ? GA : GS; const int ct = (pn < 24 ? pn - 20 : pn - 24) * 256;
#pragma unroll
            for (int ai = 0; ai < 2; ++ai)
#pragma unroll
                for (int m = 0; m < 4; ++m) {
                    const int row = row0 + ai * 128 + m * 16; const float rs = rs1[row];
#pragma unroll
                    for (int bj = 0; bj < 2; ++bj) {
                        const f32x4 v0 = acc[ai][bj][m][0] * rs, v1 = acc[ai][bj][m][1] * rs;
                        bf16* p = dst + (size_t)row * D + ct + bj * 128 + cl;
                        v2u w0, w1; w0.x = pkbf(sigmoidf_(v0[0]), sigmoidf_(v0[1])); w0.y = pkbf(sigmoidf_(v0[2]), sigmoidf_(v0[3]));
                        w1.x = pkbf(sigmoidf_(v1[0]), sigmoidf_(v1[1])); w1.y = pkbf(sigmoidf_(v1[2]), sigmoidf_(v1[3]));
                        *(v2u*)p = w0; *(v2u*)(p + 16) = w1;
                    }
                }
        }
    }
};

struct EpiGlu {
    static constexpr bool PERM = true, AFTER_DRAIN = false;
    const bf16* GS; bf16* MRG;
    __device__ __forceinline__ void operator()(const f32x4 (&acc)[2][2][4][2], const pg8::Unit& u, int wr, int wc, int fr, int fq) const {
        const int row0 = u.pm * 256 + wr * 64 + fr, f0 = u.pn * 128 + wc * 32 + 8 * fq;
#pragma unroll
        for (int ai = 0; ai < 2; ++ai)
#pragma unroll
            for (int m = 0; m < 4; ++m) {
                const size_t off = (size_t)(row0 + ai * 128 + m * 16) * D + f0;
                const v4u g = *(const v4u*)(GS + off);
                const float gv[8] = {bflo(g.x), bfhi(g.x), bflo(g.y), bfhi(g.y), bflo(g.z), bfhi(g.z), bflo(g.w), bfhi(g.w)};
                float o[8];
#pragma unroll
                for (int n = 0; n < 2; ++n)
#pragma unroll
                    for (int j = 0; j < 4; ++j) o[4 * n + j] = gv[4 * n + j] * acc[ai][0][m][n][j] * sigmoidf_(acc[ai][1][m][n][j]);
                v4u w; w.x = pkbf(o[0], o[1]); w.y = pkbf(o[2], o[3]); w.z = pkbf(o[4], o[5]); w.w = pkbf(o[6], o[7]);
                *(v4u*)(MRG + off) = w;
            }
    }
};
struct EpiProj {
    static constexpr bool PERM = true, AFTER_DRAIN = false;
    const bf16* GA; bf16* MRG;
    __device__ __forceinline__ void operator()(const f32x4 (&acc)[2][2][4][2], const pg8::Unit& u, int wr, int wc, int fr, int fq) const {
        const int row0 = u.pm * 256 + wr * 64 + fr, c0 = u.pn * 256 + wc * 32 + 8 * fq;
#pragma unroll
        for (int ai = 0; ai < 2; ++ai)
#pragma unroll
            for (int m = 0; m < 4; ++m)
#pragma unroll
                for (int bj = 0; bj < 2; ++bj) {
                    const size_t off = (size_t)(row0 + ai * 128 + m * 16) * D + c0 + bj * 128;
                    const v4u g = *(const v4u*)(GA + off), p = *(const v4u*)(MRG + off);
                    const float gv[8] = {bflo(g.x), bfhi(g.x), bflo(g.y), bfhi(g.y), bflo(g.z), bfhi(g.z), bflo(g.w), bfhi(g.w)};
                    const float pv[8] = {bflo(p.x), bfhi(p.x), bflo(p.y), bfhi(p.y), bflo(p.z), bfhi(p.z), bflo(p.w), bfhi(p.w)};
                    float o[8];
#pragma unroll
                    for (int n = 0; n < 2; ++n)
#pragma unroll
                        for (int j = 0; j < 4; ++j) o[4 * n + j] = gv[4 * n + j] * acc[ai][bj][m][n][j] + pv[4 * n + j];
                    v4u w; w.x = pkbf(o[0], o[1]); w.y = pkbf(o[2], o[3]); w.z = pkbf(o[4], o[5]); w.w = pkbf(o[6], o[7]);
                    *(v4u*)(MRG + off) = w;
                }
    }
};
struct EpiStore {
    static constexpr bool PERM = true, AFTER_DRAIN = false;
    bf16* O; int ldc;
    __device__ __forceinline__ void operator()(const f32x4 (&acc)[2][2][4][2], const pg8::Unit& u, int wr, int wc, int fr, int fq) const {
        const int row0 = u.pm * 256 + wr * 64 + fr, c0 = u.pn * 256 + wc * 32 + 8 * fq;
#pragma unroll
        for (int ai = 0; ai < 2; ++ai)
#pragma unroll
            for (int m = 0; m < 4; ++m)
#pragma unroll
                for (int bj = 0; bj < 2; ++bj) {
                    const f32x4 v0 = acc[ai][bj][m][0], v1 = acc[ai][bj][m][1];
                    v4u w; w.x = pkbf(v0[0], v0[1]); w.y = pkbf(v0[2], v0[3]); w.z = pkbf(v1[0], v1[1]); w.w = pkbf(v1[2], v1[3]);
                    *(v4u*)(O + (size_t)(row0 + ai * 128 + m * 16) * ldc + c0 + bj * 128) = w;
                }
    }
};
template <int MODE, bool WB, bool SSQ> struct EpiRes {
    static constexpr bool PERM = false, AFTER_DRAIN = false;
    const float* base; float* out; bf16* ob; float* ssq; const bf16* PP;
    __device__ __forceinline__ void operator()(const f32x4 (&acc)[2][2][4][2], const pg8::Unit& u, int wr, int wc, int fr, int fq) const {
        const int row0 = u.pm * 256 + wr * 64 + fr, c0 = u.pn * 256 + wc * 32 + 4 * fq;
#pragma unroll
        for (int ai = 0; ai < 2; ++ai)
#pragma unroll
            for (int m = 0; m < 4; ++m) {
                const int row = row0 + ai * 128 + m * 16; float sq = 0.f;
#pragma unroll
                for (int bj = 0; bj < 2; ++bj)
#pragma unroll
                    for (int n = 0; n < 2; ++n) {
                        const size_t off = (size_t)row * D + c0 + bj * 128 + n * 16;
                        f32x4 a = acc[ai][bj][m][n];
                        if (MODE == 1) { const v2u pw = *(const v2u*)(PP + off); a[0] = sigmoidf_(a[0]) * bflo(pw.x); a[1] = sigmoidf_(a[1]) * bfhi(pw.x); a[2] = sigmoidf_(a[2]) * bflo(pw.y); a[3] = sigmoidf_(a[3]) * bfhi(pw.y); }
                        const f32x4 h = *(const f32x4*)(base + off) + a;
                        *(f32x4*)(out + off) = h;
                        if (WB) { v2u w; w.x = pkbf(h[0], h[1]); w.y = pkbf(h[2], h[3]); *(v2u*)(ob + off) = w; }
                        if (SSQ) sq += (h[0] * h[0] + h[1] * h[1]) + (h[2] * h[2] + h[3] * h[3]);
                    }
                if (SSQ) { sq += __shfl_xor(sq, 16); sq += __shfl_xor(sq, 32); if (fq == 0) ssq[(size_t)row * 16 + u.pn * 4 + wc] = sq; }
                asm volatile("" ::: "memory");
            }
    }
};
struct EpiSwiglu {
    static constexpr bool PERM = true, AFTER_DRAIN = false;
    const float* ssq; bf16* ACT;
    __device__ __forceinline__ void operator()(const f32x4 (&acc)[2][2][4][2], const pg8::Unit& u, int wr, int wc, int fr, int fq) const {
        const int row0 = u.pm * 256 + wr * 64 + fr, f0 = u.pn * 128 + wc * 32 + 8 * fq;
#pragma unroll
        for (int ai = 0; ai < 2; ++ai)
#pragma unroll
            for (int m = 0; m < 4; ++m) {
                const int row = row0 + ai * 128 + m * 16;
                const f32x4* sp = (const f32x4*)(ssq + (size_t)row * 16);
                const f32x4 s0 = sp[0], s1 = sp[1], s2 = sp[2], s3 = sp[3];
                const float tot = ((s0.x + s0.y) + (s0.z + s0.w)) + ((s1.x + s1.y) + (s1.z + s1.w)) + ((s2.x + s2.y) + (s2.z + s2.w)) + ((s3.x + s3.y) + (s3.z + s3.w));
                const float rs = 1.0f / sqrtf(tot * (1.0f / D) + EPS);
                float o[8];
#pragma unroll
                for (int n = 0; n < 2; ++n)
#pragma unroll
                    for (int j = 0; j < 4; ++j) { const float g = acc[ai][0][m][n][j] * rs, uu = acc[ai][1][m][n][j] * rs; o[4 * n + j] = g * sigmoidf_(g) * uu; }
                v4u w; w.x = pkbf(o[0], o[1]); w.y = pkbf(o[2], o[3]); w.z = pkbf(o[4], o[5]); w.w = pkbf(o[6], o[7]);
                *(v4u*)(ACT + (size_t)row * DFF + f0) = w;
            }
    }
};

constexpr int KV_STRIDE = 272;
constexpr int V_LDS_OFF = 256 * KV_STRIDE;
__device__ __forceinline__ void attn_unit(LAS unsigned char* lds, bf16* Q, const bf16* K, const bf16* V, float* LSE, int unit, int tid, int wid, int lane) {
    const int grp = unit >> 9, hh = (unit >> 7) & 3, rn = unit & 127;
    const int dl = grp == 0 ? 1 : (grp == 1 ? 4 : 16);
    const int r = rn % dl, n = rn / dl;
    const int col0 = (grp * 4 + hh) * 128;
    __syncthreads();
    {
        const int ch = tid & 15, rw = tid >> 4;
        for (int p0 = (n == 0 ? 128 : 0); p0 < 256; p0 += 128) {
            v4u kv[4], vv[4];
#pragma unroll
            for (int q = 0; q < 4; ++q) { const int kk = p0 + 32 * q + rw; const size_t tok = (size_t)((n - 1) * 128 + kk) * dl + r;
                kv[q] = *(const v4u*)(K + tok * QKW + col0 + ch * 8); vv[q] = *(const v4u*)(V + tok * QKW + col0 + ch * 8); }
#pragma unroll
            for (int q = 0; q < 4; ++q) { const int kk = p0 + 32 * q + rw;
                *(LAS v4u*)(lds + kk * KV_STRIDE + ch * 16) = kv[q]; *(LAS v4u*)(lds + V_LDS_OFF + kk * KV_STRIDE + ch * 16) = vv[q]; }
        }
    }
    __syncthreads();
    const int l16 = lane & 15, g = lane >> 4;
    const int qi = 16 * wid + l16;
    const size_t tokq = (size_t)(n * 128 + qi) * dl + r;
    bf16* qp = Q + tokq * QKW + col0;
    bf16x8 qf[4];
#pragma unroll
    for (int ks = 0; ks < 4; ++ks) qf[ks] = *(const bf16x8*)(qp + 32 * ks + 8 * g);
    f32x4 st[9];
    float mx = -INFINITY;
#pragma unroll
    for (int i = 0; i < 9; ++i) {
        const int c = wid + i;
        st[i] = (f32x4){0.f, 0.f, 0.f, 0.f};
        if (c >= 8 || n > 0) {
            const LAS unsigned char* kp = lds + (16 * c + l16) * KV_STRIDE + 16 * g;
#pragma unroll
            for (int ks = 0; ks < 4; ++ks) { const bf16x8 kf = *(const LAS bf16x8*)(kp + 64 * ks); st[i] = __builtin_amdgcn_mfma_f32_16x16x32_bf16(kf, qf[ks], st[i], 0, 0, 0); }
#pragma unroll
            for (int rr = 0; rr < 4; ++rr) { const int kk = 16 * c + 4 * g + rr; const bool ok = kk < 128 ? (kk >= qi) : (kk - 128 <= qi); st[i][rr] = ok ? st[i][rr] : -INFINITY; mx = fmaxf(mx, st[i][rr]); }
        } else {
            st[i] = (f32x4){-INFINITY, -INFINITY, -INFINITY, -INFINITY};
        }
    }
    mx = fmaxf(mx, __shfl_xor(mx, 16)); mx = fmaxf(mx, __shfl_xor(mx, 32));
    float den = 0.f; s16x4 pb[9];
#pragma unroll
    for (int i = 0; i < 9; ++i) {
        float p[4];
#pragma unroll
        for (int rr = 0; rr < 4; ++rr) { p[rr] = __builtin_amdgcn_exp2f(st[i][rr] - mx); den += p[rr]; }
        v2u w; w.x = pkbf(p[0], p[1]); w.y = pkbf(p[2], p[3]);
        pb[i] = __builtin_bit_cast(s16x4, w);
    }
    den += __shfl_xor(den, 16); den += __shfl_xor(den, 32);
    f32x4 ot[8];
#pragma unroll
    for (int nt = 0; nt < 8; ++nt) ot[nt] = (f32x4){0.f, 0.f, 0.f, 0.f};
#pragma unroll
    for (int i = 0; i < 9; ++i) {
        const int c = wid + i;
        if (c >= 8 || n > 0) {
            const LAS unsigned char* vp = lds + V_LDS_OFF + (16 * c + 4 * g + (l16 >> 2)) * KV_STRIDE + 8 * (l16 & 3);
#pragma unroll
            for (int nt = 0; nt < 8; ++nt) {
                const s16x4 vf = __builtin_bit_cast(s16x4, __builtin_amdgcn_ds_read_tr16_b64_v4i16((LAS s16x4*)(vp + 32 * nt)));
                ot[nt] = __builtin_amdgcn_mfma_f32_16x16x16bf16_1k(vf, pb[i], ot[nt], 0, 0, 0);
            }
        }
    }
    const float inv = 1.0f / den;
#pragma unroll
    for (int nt = 0; nt < 8; ++nt) { v2u w; w.x = pkbf(ot[nt][0] * inv, ot[nt][1] * inv); w.y = pkbf(ot[nt][2] * inv, ot[nt][3] * inv); *(v2u*)(qp + 16 * nt + 4 * g) = w; }
    if (g == 0) LSE[((size_t)grp * M + tokq) * 4 + hh] = mx + __builtin_amdgcn_logf(den);
}

__device__ __forceinline__ void merge_rows(const bf16* Q, const float* LSE, bf16* ATT, int gw, int NGW, int lane) {
    const int hh = lane >> 4, ch = lane & 15;
    for (int t = gw; t < M; t += NGW) {
        const float l0 = LSE[((size_t)0 * M + t) * 4 + hh], l1 = LSE[((size_t)1 * M + t) * 4 + hh], l2 = LSE[((size_t)2 * M + t) * 4 + hh];
        const float mx = fmaxf(l0, fmaxf(l1, l2));
        float w0 = __builtin_amdgcn_exp2f(l0 - mx), w1 = __builtin_amdgcn_exp2f(l1 - mx), w2 = __builtin_amdgcn_exp2f(l2 - mx);
        const float inv = 1.0f / (w0 + w1 + w2); w0 *= inv; w1 *= inv; w2 *= inv;
        const bf16* qb = Q + (size_t)t * QKW + hh * 128 + ch * 8;
        const v4u a = *(const v4u*)qb, b = *(const v4u*)(qb + 512), c = *(const v4u*)(qb + 1024);
        v4u o;
        o.x = pkbf(w0 * bflo(a.x) + w1 * bflo(b.x) + w2 * bflo(c.x), w0 * bfhi(a.x) + w1 * bfhi(b.x) + w2 * bfhi(c.x));
        o.y = pkbf(w0 * bflo(a.y) + w1 * bflo(b.y) + w2 * bflo(c.y), w0 * bfhi(a.y) + w1 * bfhi(b.y) + w2 * bfhi(c.y));
        o.z = pkbf(w0 * bflo(a.z) + w1 * bflo(b.z) + w2 * bflo(c.z), w0 * bfhi(a.z) + w1 * bfhi(b.z) + w2 * bfhi(c.z));
        o.w = pkbf(w0 * bflo(a.w) + w1 * bflo(b.w) + w2 * bflo(c.w), w0 * bfhi(a.w) + w1 * bfhi(b.w) + w2 * bfhi(c.w));
        *(v4u*)(ATT + (size_t)t * 512 + hh * 128 + ch * 8) = o;
    }
}

constexpr int SCH = 128, NCH = M / SCH;
struct SsmLane { float ar, ai; float bbr[16], bbi[16]; };
__device__ __forceinline__ void ssm_params(const Ptrs& P, int g, int p, SsmLane& L) {
    const float dt = expf(P.in[7][g]);
    const float lr = P.in[5][g * 64 + p], li = P.in[6][g * 64 + p];
    const float mag = expf(lr * dt); float sn, cs; sincos_acc(li * dt, sn, cs);
    L.ar = mag * cs; L.ai = mag * sn;
    const float nr = L.ar - 1.0f, ni = L.ai, den = lr * lr + li * li;
    const float zr = (nr * lr + ni * li) / den, zi = (ni * lr - nr * li) / den;
    const f32x4* br = (const f32x4*)(P.in[8] + (size_t)(g * 64 + p) * 16); const f32x4* bi = (const f32x4*)(P.in[9] + (size_t)(g * 64 + p) * 16);
#pragma unroll
    for (int q = 0; q < 4; ++q) { const f32x4 a = br[q], b = bi[q];
#pragma unroll
        for (int j = 0; j < 4; ++j) { L.bbr[4 * q + j] = zr * a[j] - zi * b[j]; L.bbi[4 * q + j] = zr * b[j] + zi * a[j]; } }
}
__device__ __forceinline__ void ssm_load_u(const float* U, int t0, int g, LAS float* ul, int lane) {
#pragma unroll
    for (int it = 0; it < 8; ++it) { const int row = it * 16 + (lane >> 2), q = lane & 3;
        const f32x4 v = *(const f32x4*)(U + (size_t)(t0 + row) * SSMW + g * 16 + 4 * q); *(LAS f32x4*)(ul + row * 16 + 4 * q) = v; }
    LDS_WAIT();
}
__device__ __forceinline__ void ssm_step(const SsmLane& L, const LAS float* urow, float& hr, float& hi) {
    const LAS f32x4* u4 = (const LAS f32x4*)urow;
    float bre = 0.f, bim = 0.f;
#pragma unroll
    for (int q = 0; q < 4; ++q) { const f32x4 u = u4[q];
#pragma unroll
        for (int j = 0; j < 4; ++j) { bre = fmaf(u[j], L.bbr[4 * q + j], bre); bim = fmaf(u[j], L.bbi[4 * q + j], bim); } }
    const float nr = fmaf(L.ar, hr, fmaf(-L.ai, hi, bre)), ni = fmaf(L.ar, hi, fmaf(L.ai, hr, bim));
    hr = nr; hi = ni;
}
__device__ __forceinline__ void ssm_pass1(const Ptrs& P, const float* U, f32x2* E, LAS unsigned char* lds, int gw, int NGW, int wave, int lane) {
    LAS float* ul = (LAS float*)(lds + wave * 16384);
    for (int unit = gw; unit < NCH * 32; unit += NGW) {
        const int g = unit & 31, c = unit >> 5;
        SsmLane L; ssm_params(P, g, lane, L);
        ssm_load_u(U, c * SCH, g, ul, lane);
        float hr = 0.f, hi = 0.f;
#pragma unroll 4
        for (int t = 0; t < SCH; ++t) ssm_step(L, ul + t * 16, hr, hi);
        E[(size_t)(c * 32 + g) * 64 + lane] = (f32x2){hr, hi};
        LDS_WAIT();
    }
}
__device__ __forceinline__ float gelu_tanh(float x) {
    const float z = 0.7978845608028654f * (x + 0.044715f * x * x * x);
    const float e = __expf(2.0f * z);
    const float th = 1.0f - 2.0f * __builtin_amdgcn_rcpf(1.0f + e);
    return 0.5f * x * (1.0f + th);
}
__device__ __forceinline__ void ssm_pass3(const Ptrs& P, const float* U, const f32x2* E, bf16* Y, LAS unsigned char* lds, int gw, int NGW, int wave, int lane) {
    LAS float* ul = (LAS float*)(lds + wave * 16384);
    LAS unsigned char* hl = lds + wave * 16384 + 8192;
    const int l16 = lane & 15, g4 = lane >> 4;
    for (int unit = gw; unit < NCH * 32; unit += NGW) {
        const int g = unit & 31, c = unit >> 5;
        SsmLane L; ssm_params(P, g, lane, L);
        bf16x8 cf[4];
#pragma unroll
        for (int ks = 0; ks < 4; ++ks) {
            const f32x4 cr = *(const f32x4*)(P.in[10] + (size_t)(g * 16 + l16) * 64 + 16 * ks + 4 * g4), ci = *(const f32x4*)(P.in[11] + (size_t)(g * 16 + l16) * 64 + 16 * ks + 4 * g4);
            v4u w; w.x = pkbf(cr[0], -ci[0]); w.y = pkbf(cr[1], -ci[1]); w.z = pkbf(cr[2], -ci[2]); w.w = pkbf(cr[3], -ci[3]);
            cf[ks] = __builtin_bit_cast(bf16x8, w);
        }
        const f32x4 dsk = *(const f32x4*)(P.in[12] + g * 16 + 4 * g4);
        ssm_load_u(U, c * SCH, g, ul, lane);
        float pr = L.ar, pi = L.ai;
#pragma unroll
        for (int s = 0; s < 7; ++s) { const float a = pr * pr - pi * pi, b = 2.0f * pr * pi; pr = a; pi = b; }
        float hr = 0.f, hi = 0.f;
        { int cc = 0;
          for (; cc + 16 <= c; cc += 16) { f32x2 e[16];
#pragma unroll
              for (int j = 0; j < 16; ++j) e[j] = E[(size_t)((cc + j) * 32 + g) * 64 + lane];
#pragma unroll
              for (int j = 0; j < 16; ++j) { const float nr = fmaf(pr, hr, fmaf(-pi, hi, e[j].x)), ni = fmaf(pr, hi, fmaf(pi, hr, e[j].y)); hr = nr; hi = ni; } }
          for (; cc < c; ++cc) { const f32x2 e = E[(size_t)(cc * 32 + g) * 64 + lane]; const float nr = fmaf(pr, hr, fmaf(-pi, hi, e.x)), ni = fmaf(pr, hi, fmaf(pi, hr, e.y)); hr = nr; hi = ni; } }
        for (int tb = 0; tb < SCH; tb += 16) {
#pragma unroll 4
            for (int tt = 0; tt < 16; ++tt) { ssm_step(L, ul + (tb + tt) * 16, hr, hi); *(LAS unsigned*)(hl + tt * 272 + lane * 4) = pkbf(hr, hi); }
            LDS_WAIT();
            f32x4 acc = {0.f, 0.f, 0.f, 0.f};
#pragma unroll
            for (int ks = 0; ks < 4; ++ks) { const bf16x8 hb = *(const LAS bf16x8*)(hl + l16 * 272 + 64 * ks + 16 * g4); acc = __builtin_amdgcn_mfma_f32_16x16x32_bf16(cf[ks], hb, acc, 0, 0, 0); }
            const f32x4 uu = *(const LAS f32x4*)(ul + (tb + l16) * 16 + 4 * g4);
            v2u w; w.x = pkbf(gelu_tanh(acc[0] + dsk[0] * uu[0]), gelu_tanh(acc[1] + dsk[1] * uu[1])); w.y = pkbf(gelu_tanh(acc[2] + dsk[2] * uu[2]), gelu_tanh(acc[3] + dsk[3] * uu[3]));
            *(v2u*)(Y + (size_t)(c * SCH + tb + l16) * SSMW + g * 16 + 4 * g4) = w;
            LDS_WAIT();
        }
    }
}

#define RLX_AGENT __ATOMIC_RELAXED, __HIP_MEMORY_SCOPE_AGENT
#define XB_TMO      128
#define XB_XCNT(j)  (256  + 64 * (j))
#define XB_XSUB(j)  (1280 + 64 * (j))
#define XB_XGEN(j)  (2304 + 64 * (j))
#define XB_TOP      3328
#define XB_TOPGEN   3392
#define XCD_BAR_WORDS 3456
#define XB_SPIN_CAP (1u << 18)

__device__ __forceinline__ unsigned xb_ld(unsigned* p)              { return __hip_atomic_load(p, __ATOMIC_RELAXED, __HIP_MEMORY_SCOPE_AGENT); }
__device__ __forceinline__ unsigned xb_add(unsigned* p, unsigned v) { return __hip_atomic_fetch_add(p, v, __ATOMIC_RELAXED, __HIP_MEMORY_SCOPE_AGENT); }
__device__ __forceinline__ unsigned xb_xcc_id() { return (unsigned)__builtin_amdgcn_s_getreg((3 << 11) | 20) & 0xFu; }
#define XB_SPIN(cond, bar) do { unsigned _sp = 0; while (cond) { __builtin_amdgcn_s_sleep(1); \
    if ((++_sp & 255u) == 0u) { if (xb_ld(&(bar)[XB_TMO])) break; if (_sp > XB_SPIN_CAP) { atomicAdd(&(bar)[XB_TMO], 1u); break; } } } } while (0)

struct XcdBarrier {
    unsigned* bar; unsigned x;
    volatile LAS unsigned* st;
};

__device__ __forceinline__ XcdBarrier xcd_barrier_post(unsigned* bar, volatile LAS unsigned* st) {
    XcdBarrier b; b.bar = bar; b.x = xb_xcc_id(); b.st = st;
    if (threadIdx.x == 0) (void)xb_add(&bar[XB_XCNT(b.x)], 1u);
    return b;
}
__device__ __forceinline__ void xcd_barrier_complete(unsigned* bar, unsigned x, unsigned& nloc, unsigned& nx) {
    const unsigned G = gridDim.x * gridDim.y * gridDim.z;
    unsigned sum, cnt, mine, sp = 0u;
    for (;;) {
        sum = 0u; cnt = 0u; mine = 0u;
#pragma unroll
        for (unsigned j = 0; j < 16; ++j) { const unsigned c = xb_ld(&bar[XB_XCNT(j)]); sum += c; cnt += (c > 0u) ? 1u : 0u; mine = (j == x) ? c : mine; }
        if (sum == G) break;
        __builtin_amdgcn_s_sleep(1);
        if ((++sp & 255u) == 0u) { if (xb_ld(&bar[XB_TMO])) break; if (sp > XB_SPIN_CAP) { atomicAdd(&bar[XB_TMO], 1u); break; } }
    }
    nloc = mine > 0u ? mine : 1u; nx = cnt > 0u ? cnt : 1u;
}

__device__ __forceinline__ void xcd_barrier(const XcdBarrier& b) {
    asm volatile("s_waitcnt vmcnt(0)" ::: "memory");
    __syncthreads();
    if (threadIdx.x == 0) {
        unsigned* bar = b.bar;
        __builtin_amdgcn_s_waitcnt(0);
        unsigned nloc = b.st[0], nx = b.st[1];
        if (nloc == 0u) { xcd_barrier_complete(bar, b.x, nloc, nx); b.st[0] = nloc; b.st[1] = nx; }
        const unsigned old = xb_add(&bar[XB_XSUB(b.x)], 1u);
        const unsigned gen = old / nloc;
        if (old + 1u == (gen + 1u) * nloc) {
            __builtin_amdgcn_fence(__ATOMIC_RELEASE, "agent");
            asm volatile("s_waitcnt vmcnt(0)" ::: "memory");
            const unsigned og = xb_add(&bar[XB_TOP], 1u);
            const unsigned tg = og / nx;
            if (og + 1u == (tg + 1u) * nx) xb_add(&bar[XB_TOPGEN], 1u);
            else XB_SPIN(xb_ld(&bar[XB_TOPGEN]) == tg, bar);
            __builtin_amdgcn_fence(__ATOMIC_ACQUIRE, "agent");
            xb_add(&bar[XB_XGEN(b.x)], 1u);
            asm volatile("s_waitcnt vmcnt(0)" ::: "memory");
        } else {
            XB_SPIN(xb_ld(&bar[XB_XGEN(b.x)]) == gen, bar);
            __builtin_amdgcn_fence(__ATOMIC_ACQUIRE, "agent");
            asm volatile("s_waitcnt vmcnt(0)" ::: "memory");
        }
    }
    __syncthreads();
}

constexpr size_t WS_BAR = 65536; constexpr int LDS_MISC_OFF = 143360;
struct PairOrder { int pm, pn;
    __device__ __forceinline__ bool next(int i, pg8::Unit& u) const { if (i >= 2) return false; u.pm = pm; u.pn = 2 * pn + i; return true; }
    __device__ __forceinline__ void a_ready(const pg8::Unit&) const {}
    __device__ __forceinline__ void done(const pg8::Unit&) const {} };
struct OneUnit { int pm, pn;
    __device__ __forceinline__ bool next(int i, pg8::Unit& u) const { if (i >= 1) return false; u.pm = pm; u.pn = pn; return true; }
    __device__ __forceinline__ void a_ready(const pg8::Unit&) const {}
    __device__ __forceinline__ void done(const pg8::Unit&) const {} };
__global__ void __launch_bounds__(NTHR, 2) mk_fwd(Args args) {
    extern __shared__ __attribute__((aligned(16))) unsigned char lds_raw[];
    LAS unsigned char* lds = (LAS unsigned char*)lds_raw;
    cg::grid_group grid = cg::this_grid();
    const int tid = threadIdx.x, lane = tid & 63, wave = __builtin_amdgcn_readfirstlane(tid >> 6);
    const int G = gridDim.x, bid = blockIdx.x;
    const int gw = bid * NWAVES + wave, NGW = G * NWAVES, gtid = bid * NTHR + tid, GT = G * NTHR;
    const Args& P = args;
    const int lo = args.ph_lo, hi = args.ph_hi;
    volatile LAS unsigned* MISC = (volatile LAS unsigned*)(lds + LDS_MISC_OFF);
    if (tid < 16) MISC[tid] = 0u;
    __syncthreads();
    XcdBarrier bar; bar.bar = (unsigned*)(args.ws + WS_BAR); bar.x = 0; bar.st = nullptr;
    if (hi - lo > 1) bar = xcd_barrier_post((unsigned*)(args.ws + WS_BAR), MISC + 8);
#ifndef PHMASK
#define PHMASK 0xFFFF
#endif
#define IN(k) (((PHMASK >> (k)) & 1) && lo <= (k) && (k) < hi)
#define SEAM(k) do { if (IN(k) && IN((k) + 1)) { xcd_barrier(bar); } } while (0)
#define Qb ((bf16*)(args.ws + WS_Q))
#define Kb ((bf16*)(args.ws + WS_K))
#define Vb ((bf16*)(args.ws + WS_V))
#define GA ((bf16*)(args.ws + WS_GA))
#define GS ((bf16*)(args.ws + WS_GS))
#define Ub ((float*)((unsigned char*)args.out + DO_U))
#define XB ((bf16*)((unsigned char*)args.out + DO_XB))
#define ATT ((bf16*)((unsigned char*)args.out + DO_ATT))
#define Yb ((bf16*)((unsigned char*)args.out + DO_Y))
#define LSE ((float*)(args.ws + WS_LSE))
#define SE ((f32x2*)(args.ws + WS_SSME))
#define MRG ((bf16*)(args.ws + WS_MRG))
#define PB ((bf16*)(args.ws + WS_PB))
#define PP ((bf16*)(args.ws + WS_PP))
#define H1B ((bf16*)(args.ws + WS_H1B))
#define ACT ((bf16*)(args.ws + WS_ACT))
#define H2B ((bf16*)(args.ws + WS_H2B))
#define ssq1 ((float*)(args.ws + WS_SSQ1))
#define ssq3 ((float*)(args.ws + WS_SSQ3))
    if (IN(0)) { p0_prologue(P, lds, gw, NGW, wave, lane, gtid, GT); }
    SEAM(0);
    if (IN(1)) {
        pg8::Gemm g{XB, (const bf16*)(args.ws + WS_WIN), M, INW, D}; pg8::StaticOrder S; S.init(M, INW, G, bid);
        EpiIn E{Qb, Kb, Vb, GA, GS, Ub, (const float*)(args.ws + WS_RS1), (const f32x4*)(args.ws + WS_ROPE)};
        pg8::gemm_phase<EpiIn, pg8::StaticOrder, true, true>(lds, g, S, E);
    }
    SEAM(1);
    if (IN(2)) {
        for (int unit = bid; unit < 1536; unit += G) attn_unit(lds, Qb, Kb, Vb, LSE, unit, tid, wave, lane);
        __syncthreads();
        ssm_pass1(P, Ub, SE, lds, gw, NGW, wave, lane);
    }
    SEAM(2);
    if (IN(3)) {
        merge_rows(Qb, LSE, ATT, gw, NGW, lane);
        ssm_pass3(P, Ub, SE, Yb, lds, gw, NGW, wave, lane);
        __syncthreads();
    }
    SEAM(3);
    if (IN(4)) {
        for (int m = gw; m < M; m += NGW) { const f32x4 v = *((const f32x4*)(P.in[1] + (size_t)m * PLE) + lane); v2u w; w.x = pkbf(v.x, v.y); w.y = pkbf(v.z, v.w); *((v2u*)(PB + (size_t)m * PLE) + lane) = w; }
        asm volatile("s_waitcnt vmcnt(0)" ::: "memory"); __syncthreads();
        pg8::StaticOrder SP; SP.init(M, D, G, bid);
        pg8::Unit up;
        for (int ip = 0; SP.next(ip, up); ++ip) {
            {
                pg8::Gemm g{Yb, (const bf16*)(args.ws + WS_WGLU), M, 2048, 512}; PairOrder S{up.pm, up.pn};
                EpiGlu E{GS, MRG};
                pg8::gemm_phase<EpiGlu, PairOrder, true, true>(lds, g, S, E);
            }
            __builtin_amdgcn_fence(__ATOMIC_ACQUIRE, "agent"); __syncthreads();
            {
                pg8::Gemm g{ATT, (const bf16*)(args.ws + WS_WPROJ), M, D, 512}; OneUnit S{up.pm, up.pn};
                EpiProj E{GA, MRG};
                pg8::gemm_phase<EpiProj, OneUnit, true, true>(lds, g, S, E);
            }
        }
    }
    SEAM(5);
    if (IN(6)) {
        {
            pg8::Gemm g{MRG, (const bf16*)(args.ws + WS_WOUT), M, D, D}; pg8::StaticOrder S; S.init(M, D, G, bid);
            EpiRes<0, true, true> E{P.in[0], P.out, H1B, ssq1, nullptr};
            pg8::gemm_phase<EpiRes<0, true, true>, pg8::StaticOrder, true, true>(lds, g, S, E);
        }
    }
    if (IN(7)) {
        {
            int kple = PLE; asm volatile("" : "+s"(kple));
            pg8::Gemm g{PB, (const bf16*)(args.ws + WS_WPLEP), M, D, kple}; pg8::StaticOrder S; S.init(M, D, G, bid);
            EpiStore E{PP, D};
            pg8::gemm_phase<EpiStore, pg8::StaticOrder, true, true>(lds, g, S, E);
        }
    }
    SEAM(7);
    if (IN(8)) {
        pg8::Gemm g{H1B, (const bf16*)(args.ws + WS_WGU), M, 2 * DFF, D}; pg8::StaticOrder S; S.init(M, 2 * DFF, G, bid);
        EpiSwiglu E{ssq1, ACT};
        pg8::gemm_phase<EpiSwiglu, pg8::StaticOrder, true, true>(lds, g, S, E);
    }
    SEAM(8);
    if (IN(9)) {
        pg8::Gemm g{ACT, (const bf16*)(args.ws + WS_WDOWN), M, D, DFF}; pg8::StaticOrder S; S.init(M, D, G, bid);
        EpiRes<0, true, false> E{P.out, P.out, H2B, nullptr, nullptr};
        pg8::gemm_phase<EpiRes<0, true, false>, pg8::StaticOrder, true, true>(lds, g, S, E);
    }
    SEAM(9);
    if (IN(10)) {
        pg8::Gemm g{H2B, (const bf16*)(args.ws + WS_WPLEG), M, D, D}; pg8::StaticOrder S; S.init(M, D, G, bid);
        EpiRes<1, false, true> E{P.out, P.out, nullptr, ssq3, PP};
        pg8::gemm_phase<EpiRes<1, false, true>, pg8::StaticOrder, true, true>(lds, g, S, E);
    }
    SEAM(10);
    if (IN(11)) {
        const f32x4* gf = (const f32x4*)P.in[23];
        for (int m = gw; m < M; m += NGW) {
            const f32x4* sp = (const f32x4*)(ssq3 + (size_t)m * 16);
            const f32x4 s0 = sp[0], s1 = sp[1], s2 = sp[2], s3 = sp[3];
            const float tot = ((s0.x + s0.y) + (s0.z + s0.w)) + ((s1.x + s1.y) + (s1.z + s1.w)) + ((s2.x + s2.y) + (s2.z + s2.w)) + ((s3.x + s3.y) + (s3.z + s3.w));
            const float rs = 1.0f / sqrtf(tot * (1.0f / D) + EPS);
            f32x4* o = (f32x4*)(P.out + (size_t)m * D) + lane;
#pragma unroll
            for (int j = 0; j < 4; ++j) { const f32x4 h = o[64 * j]; o[64 * j] = h * rs * gf[64 * j + lane]; }
        }
    }
    if (lo < 0) grid.sync();
#undef IN
#undef SEAM
}

extern "C" void kernel_launch(void* const* d_in, const int* in_sizes, int n_in, void* d_out, int out_size, void* d_ws, size_t ws_size, hipStream_t stream) {
    static int grid = 0;
    if (grid == 0) {
        if (n_in != 24 || out_size != M * D || ws_size < WS_END) { fprintf(stderr, "kernel_launch: unexpected shapes (n_in %d out %d ws %zu)\n", n_in, out_size, ws_size); grid = -1; return; }
        int dev = 0, cus = 0, per_cu = 0;
        hipGetDevice(&dev); hipDeviceGetAttribute(&cus, hipDeviceAttributeMultiprocessorCount, dev);
        hipFuncSetAttribute((const void*)mk_fwd, hipFuncAttributeMaxDynamicSharedMemorySize, LDS_BYTES);
        if (hipOccupancyMaxActiveBlocksPerMultiprocessor(&per_cu, (const void*)mk_fwd, NTHR, LDS_BYTES) != hipSuccess || per_cu < 1) per_cu = 1;
        (void)hipGetLastError();
        grid = cus * per_cu;
    }
    if (grid < 0) return;
    Args a{};
    for (int i = 0; i < 24; ++i) a.in[i] = (const float*)d_in[i];
    a.out = (float*)d_out; a.ws = (unsigned char*)d_ws;
#if MK_LAUNCHES == 1
    (void)hipMemsetAsync((unsigned char*)d_ws + WS_BAR, 0, 16384, stream);
    a.ph_lo = 0; a.ph_hi = NPH;
    void* kargs[] = {&a};
    hipError_t e = hipLaunchCooperativeKernel((const void*)mk_fwd, dim3(grid), dim3(NTHR), kargs, LDS_BYTES, stream);
    if (e != hipSuccess) fprintf(stderr, "cooperative launch failed: %s (grid %d)\n", hipGetErrorString(e), grid);
#else
    for (int ph = 0; ph < NPH; ++ph) { a.ph_lo = ph; a.ph_hi = ph + 1; hipLaunchKernelGGL(mk_fwd, dim3(grid), dim3(NTHR), LDS_BYTES, stream, a); }
#endif
}
```
